# Optimizing an MI355X kernel written in HIP

```python
import jax, jax.numpy as jnp
from jax import lax
import numpy as np


D_MODEL = 1024
BATCH = 8
SEQ = 2048
DEPTH = 2

BRANCH_WIDTH = 512
N_BRANCH = 4
EPS = 1e-6
S5_GROUP = 16
S5_GROUPS = BRANCH_WIDTH // S5_GROUP
S5_STATE = 64
S5_STEP_MIN = 1e-3
S5_STEP_MAX = 1e-1
SGU_CHUNK = 128
SGU_HEADS = 8
SGU_HEAD_DIM = BRANCH_WIDTH // SGU_HEADS
M2_HEAD_DIM = 64
M2_HEADS = BRANCH_WIDTH // M2_HEAD_DIM
M2_GROUPS = 2
M2_STATE = 128
M2_CONV = 4
M2_CHUNK = 128
M2_CONV_CH = BRANCH_WIDTH + 2 * M2_GROUPS * M2_STATE
M2_DT_MIN = 1e-3
M2_DT_MAX = 1e-1
SC_CONV = 3

IN_SIZES = (
    BRANCH_WIDTH, BRANCH_WIDTH,
    BRANCH_WIDTH, BRANCH_WIDTH, BRANCH_WIDTH,
    BRANCH_WIDTH, M2_CONV_CH, M2_HEADS,
    BRANCH_WIDTH, BRANCH_WIDTH, BRANCH_WIDTH, BRANCH_WIDTH,
    N_BRANCH * D_MODEL,
)
IN_DIM = int(sum(IN_SIZES))
IN_SPLITS = [int(v) for v in np.cumsum(IN_SIZES)[:-1]]

kernel_name = 'hybrid_s5_sgu_ssd_shortconv_gated_merge'


def rmsnorm(x, w):
    x32 = x.astype(jnp.float32)
    y = x32 * lax.rsqrt(jnp.mean(x32 * x32, axis=-1, keepdims=True) + EPS)
    return (y * w.astype(jnp.float32)).astype(x.dtype)


def causal_depthwise_conv(x, w):
    k, c = w.shape
    return lax.conv_general_dilated(
        x, w[:, None, :].astype(x.dtype), window_strides=(1,), padding=[(k - 1, 0)],
        dimension_numbers=('NWC', 'WIO', 'NWC'), feature_group_count=c)


def _complex_affine_combine(e1, e2):
    a1r, a1i, b1r, b1i = e1
    a2r, a2i, b2r, b2i = e2
    ar = a1r * a2r - a1i * a2i
    ai = a1r * a2i + a1i * a2r
    br = a2r * b1r - a2i * b1i + b2r
    bi = a2r * b1i + a2i * b1r + b2i
    return (ar, ai, br, bi)


def s5_branch(u, gate, lam_re, lam_im, b_re, b_im, c_re, c_im, d, log_step, w_glu):
    bsz, seq_len, _ = u.shape
    f32 = jnp.float32
    u32 = u.astype(f32).reshape(bsz, seq_len, S5_GROUPS, S5_GROUP)
    step = jnp.exp(log_step.astype(f32))[:, None]
    lr, li = lam_re.astype(f32), lam_im.astype(f32)
    mag = jnp.exp(lr * step)
    ab_re, ab_im = mag * jnp.cos(li * step), mag * jnp.sin(li * step)
    den = lr * lr + li * li
    nr = ab_re - 1.0
    coef_re = (nr * lr + ab_im * li) / den
    coef_im = (ab_im * lr - nr * li) / den
    br, bi = b_re.astype(f32), b_im.astype(f32)
    bb_re = coef_re[..., None] * br - coef_im[..., None] * bi
    bb_im = coef_re[..., None] * bi + coef_im[..., None] * br
    bu_re = jnp.einsum('blgp,gnp->blgn', u32, bb_re)
    bu_im = jnp.einsum('blgp,gnp->blgn', u32, bb_im)
    a_re = jnp.broadcast_to(ab_re, bu_re.shape)
    a_im = jnp.broadcast_to(ab_im, bu_re.shape)
    _, _, s_re, s_im = lax.associative_scan(
        _complex_affine_combine, (a_re, a_im, bu_re, bu_im), axis=1)
    y = (jnp.einsum('blgn,gpn->blgp', s_re, c_re.astype(f32))
         - jnp.einsum('blgn,gpn->blgp', s_im, c_im.astype(f32))
         + d.astype(f32) * u32)
    y = jax.nn.gelu(y.reshape(bsz, seq_len, BRANCH_WIDTH))
    y = y * jax.nn.sigmoid(y @ w_glu.astype(f32))
    return (y * jax.nn.silu(gate.astype(f32))).astype(u.dtype)


def sgu_branch(u, v, gate, ln_w, ln_b, w_s, b_s):
    bsz, seq_len, _ = u.shape
    f32 = jnp.float32
    u32 = jax.nn.gelu(u.astype(f32))
    v32 = jax.nn.gelu(v.astype(f32))
    mu = jnp.mean(v32, axis=-1, keepdims=True)
    var = jnp.mean(jnp.square(v32 - mu), axis=-1, keepdims=True)
    vn = (v32 - mu) * lax.rsqrt(var + EPS) * ln_w.astype(f32) + ln_b.astype(f32)
    vn = vn.reshape(bsz, seq_len // SGU_CHUNK, SGU_CHUNK, SGU_HEADS, SGU_HEAD_DIM)
    mask = jnp.tril(jnp.ones((SGU_CHUNK, SGU_CHUNK), dtype=bool))
    w_m = jnp.where(mask, w_s.astype(f32), 0.0)
    s = jnp.einsum('hts,bcshe->bcthe', w_m, vn) + b_s.astype(f32).T[:, :, None]
    out = u32 * s.reshape(bsz, seq_len, BRANCH_WIDTH)
    return (out * jax.nn.silu(gate.astype(f32))).astype(u.dtype)


def segsum(a):
    t = a.shape[-1]
    cs = jnp.cumsum(a, axis=-1)
    diff = cs[..., :, None] - cs[..., None, :]
    mask = jnp.tril(jnp.ones((t, t), dtype=bool))
    return jnp.where(mask, diff, -jnp.inf)


def mamba2_branch(z, xbc, dt_raw, conv_w, conv_b, dt_bias, a_log, d, norm_w):
    bsz, seq_len, _ = z.shape
    f32 = jnp.float32
    nc, q = seq_len // M2_CHUNK, M2_CHUNK
    xbc = jax.nn.silu((causal_depthwise_conv(xbc, conv_w) + conv_b).astype(f32))
    x, bm, cm = jnp.split(xbc, [BRANCH_WIDTH, BRANCH_WIDTH + M2_GROUPS * M2_STATE], axis=-1)
    rep = M2_HEADS // M2_GROUPS
    x = x.reshape(bsz, nc, q, M2_HEADS, M2_HEAD_DIM)
    bm = jnp.repeat(bm.reshape(bsz, seq_len, M2_GROUPS, M2_STATE), rep, axis=2).reshape(bsz, nc, q, M2_HEADS, M2_STATE)
    cm = jnp.repeat(cm.reshape(bsz, seq_len, M2_GROUPS, M2_STATE), rep, axis=2).reshape(bsz, nc, q, M2_HEADS, M2_STATE)
    dt = jax.nn.softplus(dt_raw.astype(f32) + dt_bias.astype(f32))
    a = -jnp.exp(a_log.astype(f32))
    da = (dt * a).reshape(bsz, nc, q, M2_HEADS).transpose(0, 3, 1, 2)
    a_cs = jnp.cumsum(da, axis=-1)
    xdt = x * dt.reshape(bsz, nc, q, M2_HEADS)[..., None]
    scores = jnp.einsum('bclhn,bcshn->bhcls', cm, bm) * jnp.exp(segsum(da))
    y_diag = jnp.einsum('bhcls,bcshp->bclhp', scores, xdt)
    decay_states = jnp.exp(a_cs[..., -1:] - a_cs)
    states = jnp.einsum('bclhn,bhcl,bclhp->bchpn', bm, decay_states, xdt)
    states = jnp.concatenate([jnp.zeros_like(states[:, :1]), states], axis=1)
    decay_chunk = jnp.exp(segsum(jnp.pad(a_cs[..., -1], ((0, 0), (0, 0), (1, 0)))))
    states = jnp.einsum('bhzc,bchpn->bzhpn', decay_chunk, states)[:, :-1]
    y_off = jnp.einsum('bclhn,bchpn,bhcl->bclhp', cm, states, jnp.exp(a_cs))
    y = y_diag + y_off + d.astype(f32)[:, None] * x
    y = y.reshape(bsz, seq_len, BRANCH_WIDTH) * jax.nn.silu(z.astype(f32))
    y = y * lax.rsqrt(jnp.mean(y * y, axis=-1, keepdims=True) + EPS) * norm_w.astype(f32)
    return y.astype(z.dtype)


def shortconv_branch(bg, cg, h, gate, conv_w):
    y = bg * causal_depthwise_conv(cg * h, conv_w)
    return y * jax.nn.silu(gate)


def setup_inputs(seed: int = 0) -> dict:
    key = jax.random.key(seed)
    ks = jax.random.split(key, 32)
    f32 = jnp.float32
    W, D, G, N, P = BRANCH_WIDTH, D_MODEL, S5_GROUPS, S5_STATE, S5_GROUP
    nrm = lambda k, shape, s: jax.random.normal(k, shape, f32) * s
    x = jax.random.normal(ks[0], (BATCH, SEQ, D), f32)
    norm_w = 1.0 + nrm(ks[1], (DEPTH, D), 0.01)
    w_in = nrm(ks[2], (DEPTH, D, IN_DIM), D ** -0.5)
    s5_lambda_re = -0.5 + nrm(ks[3], (DEPTH, G, N), 0.01)
    s5_lambda_im = jnp.pi * jnp.arange(N, dtype=f32)[None, None, :] + nrm(ks[4], (DEPTH, G, N), 0.01)
    s5_b_re = nrm(ks[5], (DEPTH, G, N, P), (2.0 * P) ** -0.5)
    s5_b_im = nrm(ks[6], (DEPTH, G, N, P), (2.0 * P) ** -0.5)
    s5_c_re = nrm(ks[7], (DEPTH, G, P, N), (2.0 * N) ** -0.5)
    s5_c_im = nrm(ks[8], (DEPTH, G, P, N), (2.0 * N) ** -0.5)
    s5_d = nrm(ks[9], (DEPTH, G, P), 1.0)
    s5_log_step = jax.random.uniform(ks[10], (DEPTH, G), f32, np.log(S5_STEP_MIN), np.log(S5_STEP_MAX))
    s5_w_glu = nrm(ks[11], (DEPTH, W, W), W ** -0.5)
    sgu_ln_w = 1.0 + nrm(ks[12], (DEPTH, W), 0.01)
    sgu_ln_b = nrm(ks[13], (DEPTH, W), 0.01)
    sgu_w = nrm(ks[14], (DEPTH, SGU_HEADS, SGU_CHUNK, SGU_CHUNK), SGU_CHUNK ** -0.5)
    sgu_b = 1.0 + nrm(ks[15], (DEPTH, SGU_HEADS, SGU_CHUNK), 0.1)
    m2_conv_w = nrm(ks[16], (DEPTH, M2_CONV, M2_CONV_CH), M2_CONV ** -0.5)
    m2_conv_b = nrm(ks[17], (DEPTH, M2_CONV_CH), 0.01)
    dt0 = jnp.exp(jax.random.uniform(ks[18], (DEPTH, M2_HEADS), f32, np.log(M2_DT_MIN), np.log(M2_DT_MAX)))
    m2_dt_bias = dt0 + jnp.log(-jnp.expm1(-dt0))
    m2_a_log = jnp.log(jax.random.uniform(ks[19], (DEPTH, M2_HEADS), f32, 1.0, 16.0))
    m2_d = 1.0 + nrm(ks[20], (DEPTH, M2_HEADS), 0.01)
    m2_norm_w = 1.0 + nrm(ks[21], (DEPTH, W), 0.01)
    sc_conv_w = nrm(ks[22], (DEPTH, SC_CONV, W), SC_CONV ** -0.5)
    merge_b = nrm(ks[23], (DEPTH, N_BRANCH, D), 0.01)
    w_branch = nrm(ks[24], (DEPTH, N_BRANCH, W, D), W ** -0.5)
    w_out = nrm(ks[25], (DEPTH, D, D), D ** -0.5)
    final_norm_w = 1.0 + nrm(ks[26], (D,), 0.01)
    return {'x': x, 'norm_w': norm_w, 'w_in': w_in,
            's5_lambda_re': s5_lambda_re, 's5_lambda_im': s5_lambda_im,
            's5_b_re': s5_b_re, 's5_b_im': s5_b_im, 's5_c_re': s5_c_re, 's5_c_im': s5_c_im,
            's5_d': s5_d, 's5_log_step': s5_log_step, 's5_w_glu': s5_w_glu,
            'sgu_ln_w': sgu_ln_w, 'sgu_ln_b': sgu_ln_b, 'sgu_w': sgu_w, 'sgu_b': sgu_b,
            'm2_conv_w': m2_conv_w, 'm2_conv_b': m2_conv_b, 'm2_dt_bias': m2_dt_bias,
            'm2_a_log': m2_a_log, 'm2_d': m2_d, 'm2_norm_w': m2_norm_w,
            'sc_conv_w': sc_conv_w, 'merge_b': merge_b, 'w_branch': w_branch,
            'w_out': w_out, 'final_norm_w': final_norm_w}


def reference(x, norm_w, w_in, s5_lambda_re, s5_lambda_im, s5_b_re, s5_b_im, s5_c_re, s5_c_im,
              s5_d, s5_log_step, s5_w_glu, sgu_ln_w, sgu_ln_b, sgu_w, sgu_b,
              m2_conv_w, m2_conv_b, m2_dt_bias, m2_a_log, m2_d, m2_norm_w,
              sc_conv_w, merge_b, w_branch, w_out, final_norm_w):
    bsz, seq_len, _ = x.shape
    for i in range(DEPTH):
        h = rmsnorm(x, norm_w[i])
        (s5_u, s5_g, sgu_u, sgu_v, sgu_g, m2_z, m2_xbc, m2_dt,
         sc_b, sc_c, sc_h, sc_g, merge_logits) = jnp.split(h @ w_in[i], IN_SPLITS, axis=-1)
        y_a = s5_branch(s5_u, s5_g, s5_lambda_re[i], s5_lambda_im[i], s5_b_re[i], s5_b_im[i],
                        s5_c_re[i], s5_c_im[i], s5_d[i], s5_log_step[i], s5_w_glu[i])
        y_b = sgu_branch(sgu_u, sgu_v, sgu_g, sgu_ln_w[i], sgu_ln_b[i], sgu_w[i], sgu_b[i])
        y_c = mamba2_branch(m2_z, m2_xbc, m2_dt, m2_conv_w[i], m2_conv_b[i], m2_dt_bias[i],
                            m2_a_log[i], m2_d[i], m2_norm_w[i])
        y_d = shortconv_branch(sc_b, sc_c, sc_h, sc_g, sc_conv_w[i])
        branches = jnp.stack([y_a, y_b, y_c, y_d], axis=2)
        branch_out = jnp.einsum('blkw,kwd->blkd', branches, w_branch[i])
        gates = jax.nn.sigmoid(
            merge_logits.reshape(bsz, seq_len, N_BRANCH, D_MODEL).astype(jnp.float32)
            + merge_b[i].astype(jnp.float32))
        merged = jnp.einsum('blkd,blkd->bld', gates, branch_out.astype(jnp.float32)).astype(x.dtype)
        x = x + merged @ w_out[i]
    return rmsnorm(x, final_norm_w)
```

```cpp
#include <hip/hip_runtime.h>
#include <hip/hip_cooperative_groups.h>
#include <cstdio>
namespace cg = cooperative_groups;

#ifndef MEGA
#define MEGA 1
#endif
#ifndef PROBE_PH
#define PROBE_PH -1
#endif
#ifndef PROBE_SUB
#define PROBE_SUB 0
#endif

#define LAS __attribute__((address_space(3)))
typedef unsigned short bf16_t;
typedef short bf16x8 __attribute__((ext_vector_type(8)));
typedef float f32x4 __attribute__((ext_vector_type(4)));
typedef float f32x2 __attribute__((ext_vector_type(2)));
typedef unsigned u32x4 __attribute__((ext_vector_type(4)));
typedef unsigned u32x2 __attribute__((ext_vector_type(2)));

constexpr int SMEM_BYTES = 150528;
#define VBID_LDS_OFF (SMEM_BYTES - 8)
constexpr int T_ = 16384, D_ = 1024, W_ = 512, SEQ_ = 2048;
constexpr int IN_DIM_ = 10248;
constexpr size_t MiB = 1048576;
constexpr size_t OFF_WINT = 0, OFF_WBT = 20 * MiB, OFF_WOUTT = 24 * MiB, OFF_WGLUT = 26 * MiB, OFF_DTRAW = 26 * MiB + MiB / 2,
                 OFF_H = 27 * MiB, OFF_A2 = 59 * MiB, OFF_S5G = 83 * MiB, OFF_SGUU = 99 * MiB, OFF_M2Z = 115 * MiB, OFF_SCB = 131 * MiB,
                 OFF_SGUV = 147 * MiB, OFF_SGUG = 163 * MiB, OFF_XBC = 179 * MiB, OFF_SCC = 211 * MiB, OFF_SCH = 227 * MiB, OFF_SCG = 243 * MiB,
                 OFF_B2TAB = 259 * MiB, OFF_GTAB = 265 * MiB, OFF_YS5 = 267 * MiB + MiB / 4, OFF_M2ST = 283 * MiB + MiB / 4,
                 OFF_YPART = 299 * MiB + MiB / 4, OFF_EACS = 315 * MiB + MiB / 4, OFF_ACH = 315 * MiB + 3 * MiB / 4, OFF_AQ = 315 * MiB + 7 * MiB / 8,
                 OFF_BAR = 316 * MiB, WS_NEED = 316 * MiB + 16384;
constexpr size_t OFF_CCONV = 0;
constexpr size_t OFF_MERGED = OFF_XBC, OFF_GS = OFF_SCC, OFF_PART = OFF_SCG;

struct P {
    const float *x, *norm_w, *w_in, *lam_re, *lam_im, *b_re, *b_im, *c_re, *c_im, *s5_d, *log_step, *w_glu, *ln_w, *ln_b, *sgu_w, *sgu_b,
        *conv_w, *conv_b, *dt_bias, *a_log, *m2_d, *m2_norm_w, *sc_w, *merge_b, *w_branch, *w_out, *final_w;
    float* out;
    char* ws;
};

typedef __bf16 bf16v2 __attribute__((ext_vector_type(2)));
__device__ __forceinline__ unsigned cvt_pk_bf16(float lo, float hi) { const f32x2 v = {lo, hi}; const bf16v2 b = __builtin_convertvector(v, bf16v2); return __builtin_bit_cast(unsigned, b); }
__device__ __forceinline__ int tidx() { int t = __builtin_amdgcn_workitem_id_x(); asm volatile("" : "+v"(t)); return t; }
#if MEGA
__device__ __forceinline__ int bidx() { int t = (int)*(volatile LAS unsigned*)(VBID_LDS_OFF); t = __builtin_amdgcn_readfirstlane(t); asm volatile("" : "+s"(t)); return t; }
#else
__device__ __forceinline__ int bidx() { int t = __builtin_amdgcn_workgroup_id_x(); asm volatile("" : "+s"(t)); return t; }
#endif
__device__ __forceinline__ int gdim() { int t = (int)__builtin_amdgcn_grid_size_x() / (int)__builtin_amdgcn_workgroup_size_x(); asm volatile("" : "+s"(t)); return t; }
__device__ __forceinline__ bf16_t f2bf(float f) { return (bf16_t)(cvt_pk_bf16(f, 0.f) & 0xffffu); }
__device__ __forceinline__ float bf2f(unsigned b) { return __uint_as_float(b << 16); }
__device__ __forceinline__ float bflo(unsigned w) { return __uint_as_float(w << 16); }
__device__ __forceinline__ float bfhi(unsigned w) { return __uint_as_float(w & 0xffff0000u); }
__device__ __forceinline__ float sigmoidf_(float z) { return __builtin_amdgcn_rcpf(1.0f + __expf(-z)); }
__device__ __forceinline__ float siluf_(float z) { return z * sigmoidf_(z); }
__device__ __forceinline__ float geluf_(float v) { const float z = 1.5957691216f * (v + 0.044715f * v * v * v); return v * sigmoidf_(z); }
__device__ __forceinline__ u32x4 pack8(const f32x4 a, const f32x4 b) { u32x4 r; r[0] = cvt_pk_bf16(a[0], a[1]); r[1] = cvt_pk_bf16(a[2], a[3]); r[2] = cvt_pk_bf16(b[0], b[1]); r[3] = cvt_pk_bf16(b[2], b[3]); return r; }
__device__ __forceinline__ void unpack8(const u32x4 r, f32x4& a, f32x4& b) { a[0] = bflo(r[0]); a[1] = bfhi(r[0]); a[2] = bflo(r[1]); a[3] = bfhi(r[1]); b[0] = bflo(r[2]); b[1] = bfhi(r[2]); b[2] = bflo(r[3]); b[3] = bfhi(r[3]); }

constexpr int BM = 256, BK = 64, HALF = 128, HTB = HALF * BK * 2, STAGE_BYTES = 8 * HTB;
__device__ __forceinline__ int lds_byte(int r, int c) { const int st = (r >> 4) * 2 + (c >> 5), rr = r & 15, cc = c & 31, ob = rr * 64 + cc * 2; return st * 1024 + (ob ^ (((ob >> 9) & 1) << 5)); }
__device__ __forceinline__ void stage_rc(int b, int& R, int& C) { const int st = b / 1024, sb = b % 1024, swz = sb ^ (((sb >> 9) & 1) << 5); R = (st >> 1) * 16 + swz / 64; C = (st & 1) * 32 + (swz % 64) / 2; }
__device__ __forceinline__ int perm32(int rho) { const int n = rho >> 4, i = rho & 15; return 8 * (i >> 2) + 4 * n + (i & 3); }

struct Unit { const char* A; const char* B; unsigned lda2, ldb2; int nt, tag, pm, pn; };

template <class Epi, class Sched>
__device__ __forceinline__ void gemm_phase(LAS unsigned char* lds, const Sched& S, const Epi& E) {
    const int tid = tidx(), wid = __builtin_amdgcn_readfirstlane(tid >> 6), lane = tid & 63, wr = wid >> 2, wc = wid & 3, fr = lane & 15, fq = lane >> 4;
    unsigned pkR = 0u, pkC = 0u;
#pragma unroll
    for (int i = 0; i < 2; ++i) { int R, C; stage_rc(tid * 16 + i * 8192, R, C); pkR |= ((unsigned)R << (8 * i)) | ((unsigned)((R & ~31) + perm32(R & 31)) << (16 + 8 * i)); pkC |= ((unsigned)C * 2u) << (8 * i); }
#define RA 0
#define RB 16
    const size_t kstep = (size_t)(BK * 2);
    const unsigned ldsw = (unsigned)wid * 1024u;
    const int aoff = lds_byte(wr * 64 + fr, fq * 8), boff = lds_byte(wc * 32 + fr, fq * 8);
#define G_SA(b, h) (((b) * 2 + (h)) * HTB)
#define G_SB(b, h) ((4 + (b) * 2 + (h)) * HTB)
#define G_STAGE(bufoff, gbase, ld2, hf, RV) do { _Pragma("unroll") for (int _i = 0; _i < 2; ++_i) \
        __builtin_amdgcn_global_load_lds((const unsigned*)((const char*)(gbase) + (size_t)(((unsigned)(hf) * HALF + ((pkR >> (RV + 8 * _i)) & 0xffu)) * (ld2) + ((pkC >> (8 * _i)) & 0xffu))), (LAS unsigned*)(lds + (bufoff) + ldsw + _i * 8192), 16, 0, 0); } while (0)
#define G_LDA(dst, b, h) do { _Pragma("unroll") for (int m = 0; m < 4; ++m) _Pragma("unroll") for (int k = 0; k < 2; ++k) dst[m][k] = *(const LAS bf16x8*)(lds + G_SA(b, h) + aoff + m * 2048 + k * 1024); } while (0)
#define G_LDB(dst, b, h) do { _Pragma("unroll") for (int n = 0; n < 2; ++n) _Pragma("unroll") for (int k = 0; k < 2; ++k) dst[n][k] = *(const LAS bf16x8*)(lds + G_SB(b, h) + boff + n * 2048 + k * 1024); } while (0)
#define G_MMA(ai, bj, At, Bt) do { __builtin_amdgcn_s_setprio(1); _Pragma("unroll") for (int m = 0; m < 4; ++m) _Pragma("unroll") for (int n = 0; n < 2; ++n) _Pragma("unroll") for (int k = 0; k < 2; ++k) \
        acc[ai][bj][m][n] = __builtin_amdgcn_mfma_f32_16x16x32_bf16(Bt[n][k], At[m][k], acc[ai][bj][m][n], 0, 0, 0); __builtin_amdgcn_s_setprio(0); } while (0)
#define G_WAIT_V(n) asm volatile("s_waitcnt vmcnt(" #n ")" ::: "memory")
#define G_WAIT_L(n) asm volatile("s_waitcnt lgkmcnt(" #n ")" ::: "memory")
#define G_BAR __builtin_amdgcn_s_barrier()
#define G_SCHED __builtin_amdgcn_sched_barrier(0)
    Unit cur, nxt; int ui = 0;
    if (!S.next(0, cur)) return;
    f32x4 acc[2][2][4][2];
#pragma unroll
    for (int a = 0; a < 2; ++a)
#pragma unroll
        for (int b = 0; b < 2; ++b)
#pragma unroll
            for (int m = 0; m < 4; ++m)
#pragma unroll
                for (int n = 0; n < 2; ++n) acc[a][b][m][n] = (f32x4){0.f, 0.f, 0.f, 0.f};
    bf16x8 At[4][2], B0[2][2], B1[2][2];
    const char* cA = cur.A; const char* cB = cur.B; unsigned cla = cur.lda2, clb = cur.ldb2;
    G_STAGE(G_SB(0, 0), cB, clb, 0, RB); G_STAGE(G_SA(0, 0), cA, cla, 0, RA); G_STAGE(G_SB(0, 1), cB, clb, 1, RB); G_STAGE(G_SA(0, 1), cA, cla, 1, RA);
    if (wr == 1) G_BAR;
    G_WAIT_V(4); G_BAR;
    G_STAGE(G_SB(1, 0), cB + kstep, clb, 0, RB); G_STAGE(G_SA(1, 0), cA + kstep, cla, 0, RA); G_STAGE(G_SB(1, 1), cB + kstep, clb, 1, RB);
    G_WAIT_V(6); G_BAR;
    for (;;) {
        const bool has_next = S.next(ui + 1, nxt);
        const char* nA = has_next ? nxt.A : cA; const char* nB = has_next ? nxt.B : cB;
        const unsigned nla = has_next ? nxt.lda2 : cla, nlb = has_next ? nxt.ldb2 : clb;
        const int nt = cur.nt;
        for (int t = 0; t < nt; t += 2) {
            const bool last = (t == nt - 2);
            const char* a1 = cA + (size_t)(t + 1) * kstep;
            const char* a2 = last ? nA : cA + (size_t)(t + 2) * kstep; const char* b2 = last ? nB : cB + (size_t)(t + 2) * kstep;
            const unsigned la2 = last ? nla : cla, lb2 = last ? nlb : clb;
            const char* a3 = a2 + kstep; const char* b3 = b2 + kstep;
            G_LDB(B0, 0, 0); G_SCHED; G_LDA(At, 0, 0); G_STAGE(G_SA(1, 1), a1, cla, 1, RA);
            G_WAIT_L(8); G_BAR; G_WAIT_L(0); G_MMA(0, 0, At, B0); G_BAR; G_SCHED;
            G_LDB(B1, 0, 1); G_STAGE(G_SB(0, 0), b2, lb2, 0, RB);
            G_BAR; G_WAIT_L(0); G_MMA(0, 1, At, B1); G_BAR;
            G_LDA(At, 0, 1); G_STAGE(G_SA(0, 0), a2, la2, 0, RA);
            G_BAR; G_WAIT_L(0); G_MMA(1, 0, At, B0); G_BAR; G_SCHED;
            G_STAGE(G_SB(0, 1), b2, lb2, 1, RB);
            G_WAIT_V(6); G_BAR; G_MMA(1, 1, At, B1); G_BAR;
            G_LDB(B0, 1, 0); G_SCHED; G_LDA(At, 1, 0); G_STAGE(G_SA(0, 1), a2, la2, 1, RA);
            G_WAIT_L(8); G_BAR; G_WAIT_L(0); G_MMA(0, 0, At, B0); G_BAR; G_SCHED;
            G_LDB(B1, 1, 1); G_STAGE(G_SB(1, 0), b3, lb2, 0, RB);
            G_BAR; G_WAIT_L(0); G_MMA(0, 1, At, B1); G_BAR;
            G_LDA(At, 1, 1); G_STAGE(G_SA(1, 0), a3, la2, 0, RA);
            G_BAR; G_WAIT_L(0); G_MMA(1, 0, At, B0); G_BAR; G_SCHED;
            G_STAGE(G_SB(1, 1), b3, lb2, 1, RB);
            G_WAIT_V(6); G_BAR; G_MMA(1, 1, At, B1); G_BAR;
        }
        if constexpr (!Epi::AFTER_DRAIN) E(acc, cur, wr, wc, fr, fq);
        if (!has_next) break;
#pragma unroll
        for (int a = 0; a < 2; ++a)
#pragma unroll
            for (int b = 0; b < 2; ++b)
#pragma unroll
                for (int m = 0; m < 4; ++m)
#pragma unroll
                    for (int n = 0; n < 2; ++n) acc[a][b][m][n] = (f32x4){0.f, 0.f, 0.f, 0.f};
        cur = nxt; cA = nA; cB = nB; cla = nla; clb = nlb; ++ui;
    }
    G_WAIT_V(0);
    if (wr == 0) G_BAR;
    G_BAR;
    if constexpr (Epi::AFTER_DRAIN) E.drained(acc, cur, wr, wc, fr, fq, lds);
#undef RA
#undef RB
#undef G_SA
#undef G_SB
#undef G_STAGE
#undef G_LDA
#undef G_LDB
#undef G_MMA
#undef G_WAIT_V
#undef G_WAIT_L
#undef G_BAR
#undef G_SCHED
}

__device__ __forceinline__ bool tile_order(long L, int nM, int nN, int& pm, int& pn) {
    const int nwg = nM * nN; if (L >= nwg) return false;
    int wgid = (int)L; { const int q = nwg / 8, r = nwg % 8, xcd = wgid % 8, off = wgid / 8; wgid = (xcd < r ? xcd * (q + 1) : r * (q + 1) + (xcd - r) * q) + off; }
    const int nig = 8 * nN, gid = wgid / nig, fm = gid * 8, gsz = (nM - fm) < 8 ? (nM - fm) : 8;
    pm = fm + ((wgid % nig) % gsz); pn = (wgid % nig) / gsz; return true;
}

struct SchedG1 { const char* A; const char* B; int G, c;
    __device__ __forceinline__ bool next(int i, Unit& u) const { int pm, pn; if (!tile_order((long)i * G + c, 64, 24, pm, pn)) return false;
        u.A = A + (size_t)pm * 256 * 2048; u.B = B + (size_t)pn * 256 * 2048; u.lda2 = 2048; u.ldb2 = 2048; u.nt = 16; u.tag = 0; u.pm = pm; u.pn = pn; return true; } };
struct EpiG1 { static constexpr bool AFTER_DRAIN = false; char* ws;
    __device__ __forceinline__ void operator()(const f32x4 (&acc)[2][2][4][2], const Unit& u, int wr, int wc, int fr, int fq) const {
        const int seg = u.pn >> 1, cb = (u.pn & 1) * 256 + wc * 32 + 8 * fq;
        bf16_t* base; int ld = 512, coff = 0;
        switch (seg) {
            case 1: base = (bf16_t*)(ws + OFF_S5G); break; case 2: base = (bf16_t*)(ws + OFF_SGUU); break; case 3: base = (bf16_t*)(ws + OFF_SGUV); break;
            case 4: base = (bf16_t*)(ws + OFF_SGUG); break; case 5: base = (bf16_t*)(ws + OFF_M2Z); break;
            case 6: base = (bf16_t*)(ws + OFF_XBC); ld = 1024; break; case 7: base = (bf16_t*)(ws + OFF_XBC); ld = 1024; coff = 512; break;
            case 8: base = (bf16_t*)(ws + OFF_SCB); break; case 9: base = (bf16_t*)(ws + OFF_SCC); break; case 10: base = (bf16_t*)(ws + OFF_SCH); break;
            case 11: base = (bf16_t*)(ws + OFF_SCG); break; default: base = (bf16_t*)(ws + OFF_A2); break;
        }
#pragma unroll
        for (int ai = 0; ai < 2; ++ai)
#pragma unroll
            for (int m = 0; m < 4; ++m) {
                const int row = u.pm * 256 + ai * 128 + wr * 64 + m * 16 + fr;
#pragma unroll
                for (int bj = 0; bj < 2; ++bj) {
                    const int col = cb + bj * 128;
                    const u32x4 v = pack8(acc[ai][bj][m][0], acc[ai][bj][m][1]);
                    bf16_t* dst;
                    if (seg == 0) dst = base + ((size_t)((col >> 4) * 1024 + (row >> 4)) * 384 + 128 + (row & 15) * 16 + (col & 15));
                    else dst = base + (size_t)row * ld + coff + col;
                    *(u32x4*)dst = v;
                }
            }
    } };

struct SchedS1 { char* ws; int G, c;
    __device__ __forceinline__ bool next(int i, Unit& u) const { const long L = (long)i * G + c; if (L >= 128) return false; const int g = (int)L >> 2, pm = (int)L & 3;
        u.A = ws + OFF_A2 + ((size_t)(g * 1024 + pm * 256) * 384 + 128) * 2; u.B = ws + OFF_GTAB + (size_t)g * 128 * 256 * 2; u.lda2 = 768; u.ldb2 = 512; u.nt = 4; u.tag = g; u.pm = pm; u.pn = 0; return true; } };
struct EpiS1 { static constexpr bool AFTER_DRAIN = true;
    __device__ __forceinline__ void drained(const f32x4 (&acc)[2][2][4][2], const Unit& u, int wr, int wc, int fr, int fq, LAS unsigned char* lds) const {
#pragma unroll
        for (int ai = 0; ai < 2; ++ai)
#pragma unroll
            for (int m = 0; m < 4; ++m) { const int row = ai * 128 + wr * 64 + m * 16 + fr;
                *(LAS u32x4*)(lds + (row * 128 + wc * 32 + 8 * fq) * 2) = pack8(acc[ai][0][m][0], acc[ai][0][m][1]); }
    } };
struct SchedS2 { char* ws; int G, c;
    __device__ __forceinline__ bool next(int i, Unit& u) const { const long L = (long)i * G + c; if (L >= 128) return false; const int g = (int)L >> 2, pm = (int)L & 3;
        u.A = ws + OFF_A2 + (size_t)(g * 1024 + pm * 256) * 768; u.B = ws + OFF_B2TAB + (size_t)g * 256 * 768; u.lda2 = 768; u.ldb2 = 768; u.nt = 6; u.tag = g; u.pm = pm; u.pn = 0; return true; } };
struct EpiS2 { static constexpr bool AFTER_DRAIN = false; char* ws; const float* dvec;
    __device__ __forceinline__ void operator()(const f32x4 (&acc)[2][2][4][2], const Unit& u, int, int, int, int) const {
        const int tq = tidx(), wr = tq >> 8, wc = (tq >> 6) & 3, fr = tq & 15, fq = (tq >> 4) & 3;
        const int g = u.tag;
        const bf16_t* a2 = (const bf16_t*)(ws + OFF_A2) + (size_t)g * 1024 * 384;
        bf16_t* ys = (bf16_t*)(ws + OFF_YS5);
#pragma unroll
        for (int bj = 0; bj < 2; ++bj) {
            const int col = bj * 128 + wc * 32 + 8 * fq, t = col >> 4, p0 = col & 15;
            const f32x4 d0 = *(const f32x4*)(dvec + g * 16 + p0), d1 = *(const f32x4*)(dvec + g * 16 + p0 + 4);
            u32x4 uu[2][4];
#pragma unroll
            for (int ai = 0; ai < 2; ++ai)
#pragma unroll
                for (int m = 0; m < 4; ++m) uu[ai][m] = *(const u32x4*)(a2 + (size_t)(u.pm * 256 + ai * 128 + wr * 64 + m * 16 + fr) * 384 + 128 + col);
#pragma unroll
            for (int ai = 0; ai < 2; ++ai)
#pragma unroll
                for (int m = 0; m < 4; ++m) { const int row = u.pm * 256 + ai * 128 + wr * 64 + m * 16 + fr;
                    f32x4 u0, u1; unpack8(uu[ai][m], u0, u1);
                    f32x4 y0 = acc[ai][bj][m][0] + d0 * u0, y1 = acc[ai][bj][m][1] + d1 * u1;
#pragma unroll
                    for (int j = 0; j < 4; ++j) { y0[j] = geluf_(y0[j]); y1[j] = geluf_(y1[j]); }
                    *(u32x4*)(ys + (size_t)(row * 16 + t) * 512 + g * 16 + p0) = pack8(y0, y1); }
            __builtin_amdgcn_sched_barrier(0);
        }
    } };
struct SchedGLU { char* ws; int G, c;
    __device__ __forceinline__ bool next(int i, Unit& u) const { const long L = (long)i * G + c; if (L >= 128) return false; const int pm = (int)L >> 1, pn = (int)L & 1;
        u.A = ws + OFF_YS5 + (size_t)pm * 256 * 1024; u.B = ws + OFF_WGLUT + (size_t)pn * 256 * 1024; u.lda2 = 1024; u.ldb2 = 1024; u.nt = 8; u.tag = 0; u.pm = pm; u.pn = pn; return true; } };
struct EpiGLU { static constexpr bool AFTER_DRAIN = false; char* ws;
    __device__ __forceinline__ void operator()(const f32x4 (&acc)[2][2][4][2], const Unit& u, int, int, int, int) const {
        const int tq = tidx(), wr = tq >> 8, wc = (tq >> 6) & 3, fr = tq & 15, fq = (tq >> 4) & 3;
        const bf16_t* ys = (const bf16_t*)(ws + OFF_YS5); bf16_t* gt = (bf16_t*)(ws + OFF_S5G);
#pragma unroll
        for (int ai = 0; ai < 2; ++ai)
#pragma unroll
            for (int bj = 0; bj < 2; ++bj) {
                u32x4 yy[4], gg[4];
#pragma unroll
                for (int m = 0; m < 4; ++m) { const size_t o = (size_t)(u.pm * 256 + ai * 128 + wr * 64 + m * 16 + fr) * 512 + u.pn * 256 + bj * 128 + wc * 32 + 8 * fq; yy[m] = *(const u32x4*)(ys + o); gg[m] = *(const u32x4*)(gt + o); }
#pragma unroll
                for (int m = 0; m < 4; ++m) { const size_t o = (size_t)(u.pm * 256 + ai * 128 + wr * 64 + m * 16 + fr) * 512 + u.pn * 256 + bj * 128 + wc * 32 + 8 * fq;
                    f32x4 y0, y1, g0, g1; unpack8(yy[m], y0, y1); unpack8(gg[m], g0, g1);
                    f32x4 r0, r1;
#pragma unroll
                    for (int j = 0; j < 4; ++j) { r0[j] = y0[j] * sigmoidf_(acc[ai][bj][m][0][j]) * siluf_(g0[j]); r1[j] = y1[j] * sigmoidf_(acc[ai][bj][m][1][j]) * siluf_(g1[j]); }
                    *(u32x4*)(gt + o) = pack8(r0, r1); }
                __builtin_amdgcn_sched_barrier(0);
            }
    } };
struct SchedP3 { char* ws; int G, c;
    __device__ __forceinline__ bool next(int i, Unit& u) const { int pm, pn; if (!tile_order((long)(i >> 3) * G + c, 64, 4, pm, pn)) return false; const int sub = i & 7, k = sub >> 1;
        if (!(sub & 1)) { u.A = ws + OFF_H + (size_t)pm * 256 * 2048; u.B = ws + OFF_WINT + (size_t)(6144 + k * 1024 + pn * 256) * 2048; u.lda2 = 2048; u.ldb2 = 2048; u.nt = 16; }
        else { const size_t yo = k == 0 ? OFF_S5G : k == 1 ? OFF_SGUU : k == 2 ? OFF_M2Z : OFF_SCB;
            u.A = ws + yo + (size_t)pm * 256 * 1024; u.B = ws + OFF_WBT + (size_t)(k * 1024 + pn * 256) * 1024; u.lda2 = 1024; u.ldb2 = 1024; u.nt = 8; }
        u.tag = sub; u.pm = pm; u.pn = pn; return true; } };
template <int KC> __device__ __forceinline__ void p3_branch_epi(const f32x4 (&acc)[2][2][4][2], char* gsb, char* psb, bf16_t* mg, const Unit& u, int wr, int wc, int fr, int fq) {
#pragma unroll
    for (int ai = 0; ai < 2; ++ai)
#pragma unroll
        for (int bj = 0; bj < 2; ++bj) {
            u32x4 pk[2], pp[4];
#pragma unroll
            for (int mp = 0; mp < 2; ++mp) pk[mp] = *(const u32x4*)(gsb + ((ai * 2 + bj) * 2 + mp) * 8192);
            if (KC > 0) {
#pragma unroll
                for (int m = 0; m < 4; ++m) pp[m] = *(const u32x4*)(psb + ((ai * 2 + bj) * 4 + m) * 8192);
            }
#pragma unroll
            for (int m = 0; m < 4; ++m) { const int slot = (ai * 2 + bj) * 4 + m; const unsigned w0 = pk[m >> 1][(m & 1) * 2], w1 = pk[m >> 1][(m & 1) * 2 + 1];
                f32x4 g0, g1;
#pragma unroll
                for (int j = 0; j < 4; ++j) { g0[j] = (float)((w0 >> (8 * j)) & 0xffu); g1[j] = (float)((w1 >> (8 * j)) & 0xffu); }
                f32x4 v0, v1;
                if (KC > 0) { f32x4 p0, p1; unpack8(pp[m], p0, p1);
#pragma unroll
                    for (int j = 0; j < 4; ++j) { v0[j] = __builtin_fmaf(g0[j], acc[ai][bj][m][0][j], p0[j]); v1[j] = __builtin_fmaf(g1[j], acc[ai][bj][m][1][j], p1[j]); } }
                else { v0 = g0 * acc[ai][bj][m][0]; v1 = g1 * acc[ai][bj][m][1]; }
                if (KC < 3) *(u32x4*)(psb + slot * 8192) = pack8(v0, v1);
                else { const int row = u.pm * 256 + ai * 128 + wr * 64 + m * 16 + fr, col = u.pn * 256 + bj * 128 + wc * 32 + 8 * fq;
                    *(u32x4*)(mg + (size_t)row * 1024 + col) = pack8(v0 * (1.0f / 255.0f), v1 * (1.0f / 255.0f)); }
            }
            __builtin_amdgcn_sched_barrier(0);
        }
}
struct EpiP3 { static constexpr bool AFTER_DRAIN = false; char* ws; const float* mb;
    __device__ __forceinline__ void operator()(const f32x4 (&acc)[2][2][4][2], const Unit& u, int, int, int, int) const {
        const int k = u.tag >> 1;
        const int tq = tidx(), wr = tq >> 8, wc = (tq >> 6) & 3, fr = tq & 15, fq = (tq >> 4) & 3;
        unsigned t16 = (unsigned)tq * 16u; asm volatile("" : "+v"(t16));
        char* gsb = ws + OFF_GS + (size_t)bidx() * (8 * 512 * 16) + t16;
        char* psb = ws + OFF_PART + (size_t)bidx() * (16 * 512 * 16) + t16;
        if (!(u.tag & 1)) {
#pragma unroll
            for (int bj = 0; bj < 2; ++bj) { const int col = u.pn * 256 + bj * 128 + wc * 32 + 8 * fq;
                const f32x4 b0 = *(const f32x4*)(mb + k * 1024 + col) * -1.4426950408889634f, b1 = *(const f32x4*)(mb + k * 1024 + col + 4) * -1.4426950408889634f;
#pragma unroll
                for (int ai = 0; ai < 2; ++ai)
#pragma unroll
                    for (int mp = 0; mp < 2; ++mp) { u32x4 pk;
#pragma unroll
                        for (int mm = 0; mm < 2; ++mm) { const int m = mp * 2 + mm; unsigned w0 = 0u, w1 = 0u;
#pragma unroll
                            for (int j = 0; j < 4; ++j) {
                                const float e0 = __builtin_amdgcn_exp2f(__builtin_fmaf(acc[ai][bj][m][0][j], -1.4426950408889634f, b0[j])), e1 = __builtin_amdgcn_exp2f(__builtin_fmaf(acc[ai][bj][m][1][j], -1.4426950408889634f, b1[j]));
                                w0 = __builtin_amdgcn_cvt_pk_u8_f32(__builtin_amdgcn_rcpf(__builtin_fmaf(e0, 1.0f / 255.0f, 1.0f / 255.0f)), j, w0);
                                w1 = __builtin_amdgcn_cvt_pk_u8_f32(__builtin_amdgcn_rcpf(__builtin_fmaf(e1, 1.0f / 255.0f, 1.0f / 255.0f)), j, w1); }
                            pk[mm * 2] = w0; pk[mm * 2 + 1] = w1; }
                        *(u32x4*)(gsb + ((ai * 2 + bj) * 2 + mp) * 8192) = pk; }
            }
        } else {
            bf16_t* mg = (bf16_t*)(ws + OFF_MERGED);
            if (k == 0) p3_branch_epi<0>(acc, gsb, psb, mg, u, wr, wc, fr, fq);
            else if (k == 3) p3_branch_epi<3>(acc, gsb, psb, mg, u, wr, wc, fr, fq);
            else p3_branch_epi<1>(acc, gsb, psb, mg, u, wr, wc, fr, fq);
        }
    } };
struct SchedP4 { char* ws; int G, c;
    __device__ __forceinline__ bool next(int i, Unit& u) const { int pm, pn; if (!tile_order((long)i * G + c, 64, 4, pm, pn)) return false;
        u.A = ws + OFF_MERGED + (size_t)pm * 256 * 2048; u.B = ws + OFF_WOUTT + (size_t)pn * 256 * 2048; u.lda2 = 2048; u.ldb2 = 2048; u.nt = 16; u.tag = 0; u.pm = pm; u.pn = pn; return true; } };
struct EpiP4 { static constexpr bool AFTER_DRAIN = false; const float* xin; float* xout;
    __device__ __forceinline__ void operator()(const f32x4 (&acc)[2][2][4][2], const Unit& u, int, int, int, int) const {
        const int tq = tidx(), wr = tq >> 8, wc = (tq >> 6) & 3, fr = tq & 15, fq = (tq >> 4) & 3;
#pragma unroll
        for (int ai = 0; ai < 2; ++ai)
#pragma unroll
            for (int bj = 0; bj < 2; ++bj) {
                f32x4 xr[4][2];
#pragma unroll
                for (int m = 0; m < 4; ++m) { const size_t o = (size_t)(u.pm * 256 + ai * 128 + wr * 64 + m * 16 + fr) * 1024 + u.pn * 256 + bj * 128 + wc * 32 + 8 * fq;
                    xr[m][0] = *(const f32x4*)(xin + o); xr[m][1] = *(const f32x4*)(xin + o + 4); }
#pragma unroll
                for (int m = 0; m < 4; ++m) { const size_t o = (size_t)(u.pm * 256 + ai * 128 + wr * 64 + m * 16 + fr) * 1024 + u.pn * 256 + bj * 128 + wc * 32 + 8 * fq;
                    *(f32x4*)(xout + o) = xr[m][0] + acc[ai][bj][m][0]; *(f32x4*)(xout + o + 4) = xr[m][1] + acc[ai][bj][m][1]; }
                __builtin_amdgcn_sched_barrier(0);
            }
    } };

constexpr int LDP = 136;
__device__ __forceinline__ bf16x8 ldfrag(const bf16_t* base, int row, int k0) { return *(const bf16x8*)(base + row * LDP + k0); }
__device__ __forceinline__ f32x4 mma16(bf16x8 a, bf16x8 b, f32x4 c) { return __builtin_amdgcn_mfma_f32_16x16x32_bf16(a, b, c, 0, 0, 0); }

__device__ __forceinline__ void transpose_tile(float* tile, const float* src, size_t ldn, bf16_t* dst, size_t ldk) {
    const int tid = tidx();
    {
        const int k0 = tid >> 6, n4 = (tid & 63) * 4;
        f32x4 v[8];
#pragma unroll
        for (int j = 0; j < 8; ++j) v[j] = *(const f32x4*)(src + (size_t)(k0 + j * 8) * ldn + n4);
#pragma unroll
        for (int j = 0; j < 8; ++j) { float* t = tile + (k0 + j * 8) * 257 + n4; t[0] = v[j][0]; t[1] = v[j][1]; t[2] = v[j][2]; t[3] = v[j][3]; }
    }
    __syncthreads();
    {
        const int n = tid >> 1, kb = (tid & 1) * 32;
#pragma unroll
        for (int j = 0; j < 4; ++j) { f32x4 a, b;
#pragma unroll
            for (int e = 0; e < 4; ++e) { a[e] = tile[(kb + j * 8 + e) * 257 + n]; b[e] = tile[(kb + j * 8 + 4 + e) * 257 + n]; }
            *(u32x4*)(dst + (size_t)n * ldk + kb + j * 8) = pack8(a, b); }
    }
    __syncthreads();
}

__device__ void phase_prep_weights(const P& p, int layer, char* smem) {
    float* tile = (float*)smem;
    const float* w_in = p.w_in + (size_t)layer * 1024 * IN_DIM_;
    for (int idx = bidx(); idx < 848; idx += gdim()) {
        if (idx < 640) { const int nt = idx >> 4, kt = idx & 15; const int n0 = nt * 256, so = n0 < 4096 ? n0 : n0 + 8;
            transpose_tile(tile, w_in + (size_t)kt * 64 * IN_DIM_ + so, IN_DIM_, (bf16_t*)(p.ws + OFF_WINT) + (size_t)n0 * 1024 + kt * 64, 1024); }
        else if (idx < 768) { const int j = idx - 640, k = j >> 5, r = j & 31, dt = r >> 3, wt = r & 7;
            transpose_tile(tile, p.w_branch + ((size_t)(layer * 4 + k) * 512 + wt * 64) * 1024 + dt * 256, 1024, (bf16_t*)(p.ws + OFF_WBT) + ((size_t)k * 1024 + dt * 256) * 512 + wt * 64, 512); }
        else if (idx < 832) { const int j = idx - 768, nt = j >> 4, kt = j & 15;
            transpose_tile(tile, p.w_out + ((size_t)layer * 1024 + kt * 64) * 1024 + nt * 256, 1024, (bf16_t*)(p.ws + OFF_WOUTT) + (size_t)nt * 256 * 1024 + kt * 64, 1024); }
        else { const int j = idx - 832, nt = j >> 3, kt = j & 7;
            transpose_tile(tile, p.w_glu + ((size_t)layer * 512 + kt * 64) * 512 + nt * 256, 512, (bf16_t*)(p.ws + OFF_WGLUT) + (size_t)nt * 256 * 512 + kt * 64, 512); }
    }
}

__device__ void phase_s5_tables(const P& p, int layer, char* smem) {
    float* pwr = (float*)smem;
    float* pwi = pwr + 64 * 17;
    float* bbr = pwi + 64 * 17;
    float* bbi = bbr + 1024;
    float* cr = bbi + 1024;
    float* ci = cr + 1024;
    float* kern = ci + 1024;
    const int tid = tidx();
    for (int job = bidx(); job < 256; job += gdim()) {
        const int g = job & 31, part = job >> 5;
        const int lg = layer * 32 + g;
        if (tid < 64) {
            const int n = tid;
            const float step = expf(p.log_step[lg]);
            const float lr = p.lam_re[lg * 64 + n], li = p.lam_im[lg * 64 + n];
            const float mag = expf(lr * step); float sn, cs; sincosf(li * step, &sn, &cs);
            const float abr = mag * cs, abi = mag * sn, den = lr * lr + li * li, nr = abr - 1.0f;
            const float cre = (nr * lr + abi * li) / den, cim = (abi * lr - nr * li) / den;
            double pr = 1.0, pi = 0.0; const double ar = (double)abr, ai = (double)abi;
            for (int j = 0; j <= 16; ++j) { pwr[n * 17 + j] = (float)pr; pwi[n * 17 + j] = (float)pi; const double t0 = pr * ar - pi * ai, t1 = pr * ai + pi * ar; pr = t0; pi = t1; }
            if (part == 0) { float* aq = (float*)(p.ws + OFF_AQ) + (g * 64 + n) * 2; aq[0] = pwr[n * 17 + 16]; aq[1] = pwi[n * 17 + 16]; }
            for (int q = 0; q < 16; ++q) { const float br = p.b_re[((size_t)lg * 64 + n) * 16 + q], bi = p.b_im[((size_t)lg * 64 + n) * 16 + q];
                bbr[n * 16 + q] = cre * br - cim * bi; bbi[n * 16 + q] = cre * bi + cim * br; }
        }
        for (int i = tid; i < 1024; i += 512) { cr[i] = p.c_re[(size_t)lg * 1024 + i]; ci[i] = p.c_im[(size_t)lg * 1024 + i]; }
        __syncthreads();
        const int nlag = 2 * part + 2;
        for (int o = tid; o < nlag * 64; o += 512) { const int j = o >> 6, pp = (o >> 2) & 15, q4 = (o & 3) * 4; f32x4 s4 = (f32x4){0.f, 0.f, 0.f, 0.f};
            for (int n = 0; n < 64; ++n) { const float wr_ = pwr[n * 17 + j], wi_ = pwi[n * 17 + j], c_r = cr[pp * 64 + n], c_i = ci[pp * 64 + n];
                const float dr_ = c_r * wr_ - c_i * wi_, di_ = c_r * wi_ + c_i * wr_;
                const f32x4 br = *(const f32x4*)(bbr + n * 16 + q4), bi = *(const f32x4*)(bbi + n * 16 + q4);
                s4 += dr_ * br - di_ * bi; }
            *(f32x4*)(kern + j * 256 + pp * 16 + q4) = s4; }
        __syncthreads();
        bf16_t* b2 = (bf16_t*)(p.ws + OFF_B2TAB) + (size_t)g * 256 * 384;
        for (int i = tid; i < 32 * 384; i += 512) { const int idx = part * 32 * 384 + i; const int r = idx / 384, k = idx - r * 384, t = r >> 4, pp = r & 15; float v;
            if (k < 64) v = cr[pp * 64 + k] * pwr[k * 17 + t + 1] - ci[pp * 64 + k] * pwi[k * 17 + t + 1];
            else if (k < 128) { const int n = k - 64; v = -(cr[pp * 64 + n] * pwi[n * 17 + t + 1] + ci[pp * 64 + n] * pwr[n * 17 + t + 1]); }
            else { const int s_ = (k - 128) >> 4, q = (k - 128) & 15; v = s_ <= t ? kern[(t - s_) * 256 + pp * 16 + q] : 0.f; }
            b2[idx] = f2bf(v); }
        bf16_t* gt = (bf16_t*)(p.ws + OFF_GTAB) + (size_t)g * 128 * 256;
        for (int i = tid; i < 16 * 256; i += 512) { const int idx = part * 16 * 256 + i; const int np = idx >> 8, kk = idx & 255, s_ = kk >> 4, q = kk & 15, n = np & 63;
            const float wr_ = pwr[n * 17 + 15 - s_], wi_ = pwi[n * 17 + 15 - s_], br = bbr[n * 16 + q], bi = bbi[n * 16 + q];
            gt[idx] = f2bf(np < 64 ? (wr_ * br - wi_ * bi) : (wr_ * bi + wi_ * br)); }
        if (g == 31) { bf16_t* pad = (bf16_t*)(p.ws + OFF_GTAB) + (size_t)32 * 128 * 256 + part * 16 * 256; for (int i = tid; i < 16 * 256; i += 512) pad[i] = 0; }
        __syncthreads();
    }
}

__device__ __forceinline__ float wave_sum(float v) {
#pragma unroll
    for (int o = 32; o > 0; o >>= 1) v += __shfl_xor(v, o, 64);
    return v;
}

__device__ void phase_rmsnorm_h(const P& p, int layer, const float* xin, char* smem) {
    const int tid = tidx(), wid = tid >> 6, lane = tid & 63;
    const float* w_in = p.w_in + (size_t)layer * 1024 * IN_DIM_;
    f32x4 wq[16][2];
#pragma unroll
    for (int j = 0; j < 4; ++j)
#pragma unroll
        for (int e = 0; e < 4; ++e) { const size_t k = (size_t)(j * 256 + lane * 4 + e); wq[j * 4 + e][0] = *(const f32x4*)(w_in + k * IN_DIM_ + 4096); wq[j * 4 + e][1] = *(const f32x4*)(w_in + k * IN_DIM_ + 4100); }
    const float* nw = p.norm_w + layer * 1024;
    bf16_t* h = (bf16_t*)(p.ws + OFF_H); float* dtraw = (float*)(p.ws + OFF_DTRAW);
    f32x4 wv[4];
#pragma unroll
    for (int j = 0; j < 4; ++j) wv[j] = *(const f32x4*)(nw + j * 256 + lane * 4);
    for (int row0 = (bidx() * 8 + wid) * 2; row0 < T_; row0 += gdim() * 16) {
        f32x4 v[2][4]; float ss[2] = {0.f, 0.f};
#pragma unroll
        for (int r = 0; r < 2; ++r)
#pragma unroll
            for (int j = 0; j < 4; ++j) v[r][j] = *(const f32x4*)(xin + (size_t)(row0 + r) * 1024 + j * 256 + lane * 4);
#pragma unroll
        for (int r = 0; r < 2; ++r)
#pragma unroll
            for (int j = 0; j < 4; ++j) ss[r] += v[r][j][0] * v[r][j][0] + v[r][j][1] * v[r][j][1] + v[r][j][2] * v[r][j][2] + v[r][j][3] * v[r][j][3];
        ss[0] = wave_sum(ss[0]); ss[1] = wave_sum(ss[1]);
#pragma unroll
        for (int r = 0; r < 2; ++r) {
            const float rstd = rsqrtf(ss[r] * (1.0f / 1024.0f) + 1e-6f);
            float dacc[8];
#pragma unroll
            for (int e = 0; e < 8; ++e) dacc[e] = 0.f;
#pragma unroll
            for (int j = 0; j < 4; ++j) { const f32x4 hv = v[r][j] * rstd * wv[j];
                u32x2 o; o[0] = cvt_pk_bf16(hv[0], hv[1]); o[1] = cvt_pk_bf16(hv[2], hv[3]);
                *(u32x2*)(h + (size_t)(row0 + r) * 1024 + j * 256 + lane * 4) = o;
#pragma unroll
                for (int e = 0; e < 4; ++e) { const f32x4 w0 = wq[j * 4 + e][0], w1 = wq[j * 4 + e][1];
#pragma unroll
                    for (int q = 0; q < 4; ++q) { dacc[q] += hv[e] * w0[q]; dacc[4 + q] += hv[e] * w1[q]; } }
            }
            const bool h32 = (lane & 32) != 0, h16 = (lane & 16) != 0, h8 = (lane & 8) != 0;
            float a4[4];
#pragma unroll
            for (int e = 0; e < 4; ++e) { const float send = h32 ? dacc[e] : dacc[4 + e]; const float keep = h32 ? dacc[4 + e] : dacc[e]; a4[e] = keep + __shfl_xor(send, 32, 64); }
            float a2[2];
#pragma unroll
            for (int e = 0; e < 2; ++e) { const float send = h16 ? a4[e] : a4[2 + e]; const float keep = h16 ? a4[2 + e] : a4[e]; a2[e] = keep + __shfl_xor(send, 16, 64); }
            float a1; { const float send = h8 ? a2[0] : a2[1]; const float keep = h8 ? a2[1] : a2[0]; a1 = keep + __shfl_xor(send, 8, 64); }
            a1 += __shfl_xor(a1, 4, 64); a1 += __shfl_xor(a1, 2, 64); a1 += __shfl_xor(a1, 1, 64);
            if ((lane & 7) == 0) { const int e = (h32 ? 4 : 0) + (h16 ? 2 : 0) + (h8 ? 1 : 0); dtraw[(size_t)(row0 + r) * 8 + e] = a1; }
        }
    }
    __syncthreads();
}

__device__ void phase_final_norm(const P& p) {
    const int tid = tidx(), wid = tid >> 6, lane = tid & 63;
    f32x4 wv[4];
#pragma unroll
    for (int j = 0; j < 4; ++j) wv[j] = *(const f32x4*)(p.final_w + j * 256 + lane * 4);
    const int rstep = gdim() * 16;
    f32x4 vn[2][4];
    { const int r0_ = (bidx() * 8 + wid) * 2;
#pragma unroll
        for (int r = 0; r < 2; ++r)
#pragma unroll
            for (int j = 0; j < 4; ++j) vn[r][j] = *(const f32x4*)(p.out + (size_t)(r0_ + r) * 1024 + j * 256 + lane * 4); }
    for (int row0 = (bidx() * 8 + wid) * 2; row0 < T_; row0 += rstep) {
        f32x4 v[2][4]; float ss[2] = {0.f, 0.f};
#pragma unroll
        for (int r = 0; r < 2; ++r)
#pragma unroll
            for (int j = 0; j < 4; ++j) v[r][j] = vn[r][j];
        { const int rn = row0 + rstep < T_ ? row0 + rstep : row0;
#pragma unroll
            for (int r = 0; r < 2; ++r)
#pragma unroll
                for (int j = 0; j < 4; ++j) vn[r][j] = *(const f32x4*)(p.out + (size_t)(rn + r) * 1024 + j * 256 + lane * 4); }
#pragma unroll
        for (int r = 0; r < 2; ++r)
#pragma unroll
            for (int j = 0; j < 4; ++j) ss[r] += v[r][j][0] * v[r][j][0] + v[r][j][1] * v[r][j][1] + v[r][j][2] * v[r][j][2] + v[r][j][3] * v[r][j][3];
        ss[0] = wave_sum(ss[0]); ss[1] = wave_sum(ss[1]);
#pragma unroll
        for (int r = 0; r < 2; ++r) { const float rstd = rsqrtf(ss[r] * (1.0f / 1024.0f) + 1e-6f);
#pragma unroll
            for (int j = 0; j < 4; ++j) *(f32x4*)(p.out + (size_t)(row0 + r) * 1024 + j * 256 + lane * 4) = v[r][j] * rstd * wv[j]; }
    }
}

__device__ void phase_sgu(const P& p, int layer, char* smem, int task0, int tstride) {
    bf16_t* vnT = (bf16_t*)smem;
    float* hs = (float*)(smem + 8 * 64 * LDP * 2);
    float* rs = hs + 8 * 128 * 2;
    const int tid = tidx(), w = tid >> 6, lane = tid & 63;
    const bf16_t* vbuf = (const bf16_t*)(p.ws + OFF_SGUV); const bf16_t* gbuf = (const bf16_t*)(p.ws + OFF_SGUG); bf16_t* ubuf = (bf16_t*)(p.ws + OFF_SGUU);
    const float* lnw = p.ln_w + layer * 512 + w * 64; const float* lnb = p.ln_b + layer * 512 + w * 64;
    const float* Wm = p.sgu_w + ((size_t)layer * 8 + w) * 128 * 128; const float* bs = p.sgu_b + (layer * 8 + w) * 128;
    for (int task = task0; task < 128; task += tstride) {
        const size_t tok0 = (size_t)task * 128;
        const int r8 = lane >> 3, e0 = (lane & 7) * 8;
#pragma unroll 1
        for (int hb = 0; hb < 2; ++hb) {
        u32x4 vraw[8];
#pragma unroll
        for (int it = 0; it < 8; ++it) vraw[it] = *(const u32x4*)(vbuf + (tok0 + (hb * 8 + it) * 8 + r8) * 512 + w * 64 + e0);
#pragma unroll
        for (int it = 0; it < 8; ++it) { const int s = (hb * 8 + it) * 8 + r8;
            f32x4 a, b; unpack8(vraw[it], a, b);
            float sm = 0.f, sq = 0.f;
#pragma unroll
            for (int j = 0; j < 4; ++j) { const float x0 = geluf_(a[j]), x1 = geluf_(b[j]); sm += x0 + x1; sq += x0 * x0 + x1 * x1; }
#pragma unroll
            for (int o = 1; o < 8; o <<= 1) { sm += __shfl_xor(sm, o, 64); sq += __shfl_xor(sq, o, 64); }
            if ((lane & 7) == 0) { hs[(w * 128 + s) * 2] = sm; hs[(w * 128 + s) * 2 + 1] = sq; }
        }
        }
        __syncthreads();
        if (tid < 128) { float sm = 0.f, sq = 0.f;
#pragma unroll
            for (int hh = 0; hh < 8; ++hh) { sm += hs[(hh * 128 + tid) * 2]; sq += hs[(hh * 128 + tid) * 2 + 1]; }
            const float mu = sm * (1.0f / 512.0f); const float var = fmaxf(sq * (1.0f / 512.0f) - mu * mu, 0.f);
            rs[tid * 2] = mu; rs[tid * 2 + 1] = rsqrtf(var + 1e-6f); }
        __syncthreads();
        {
            const f32x4 lw0 = *(const f32x4*)(lnw + e0), lw1 = *(const f32x4*)(lnw + e0 + 4), lb0 = *(const f32x4*)(lnb + e0), lb1 = *(const f32x4*)(lnb + e0 + 4);
            bf16_t* my = vnT + (size_t)w * 64 * LDP;
#pragma unroll 1
            for (int hb = 0; hb < 2; ++hb) {
            u32x4 vr2[8];
#pragma unroll
            for (int it = 0; it < 8; ++it) vr2[it] = *(const u32x4*)(vbuf + (tok0 + (hb * 8 + it) * 8 + r8) * 512 + w * 64 + e0);
#pragma unroll
            for (int it = 0; it < 8; ++it) { const int s = (hb * 8 + it) * 8 + r8;
                f32x4 a, b; unpack8(vr2[it], a, b);
                const float mu = rs[s * 2], rstd = rs[s * 2 + 1];
#pragma unroll
                for (int j = 0; j < 4; ++j) { my[(e0 + j) * LDP + s] = f2bf((geluf_(a[j]) - mu) * rstd * lw0[j] + lb0[j]); my[(e0 + 4 + j) * LDP + s] = f2bf((geluf_(b[j]) - mu) * rstd * lw1[j] + lb1[j]); }
            }
            }
        }
        __syncthreads();
        {
            const bf16_t* my = vnT + (size_t)w * 64 * LDP;
            const int fr = lane & 15, kq = lane >> 4;
            f32x4 wq[4][2]; u32x2 uq[4], gq[4]; float btq;
#define SGU_LOAD(NT) do { const int t_ = (NT) * 16 + fr; \
                _Pragma("unroll") for (int ks = 0; ks < 4; ++ks) { wq[ks][0] = *(const f32x4*)(Wm + (size_t)t_ * 128 + ks * 32 + kq * 8); wq[ks][1] = *(const f32x4*)(Wm + (size_t)t_ * 128 + ks * 32 + kq * 8 + 4); } \
                _Pragma("unroll") for (int mt = 0; mt < 4; ++mt) { const size_t o_ = (tok0 + t_) * 512 + w * 64 + mt * 16 + kq * 4; uq[mt] = *(const u32x2*)(ubuf + o_); gq[mt] = *(const u32x2*)(gbuf + o_); } \
                btq = bs[t_]; } while (0)
            SGU_LOAD(0);
#pragma unroll 1
            for (int nt = 0; nt < 8; ++nt) {
                f32x4 acc[4];
#pragma unroll
                for (int mt = 0; mt < 4; ++mt) acc[mt] = (f32x4){0.f, 0.f, 0.f, 0.f};
                const int t = nt * 16 + fr;
                bf16x8 bfr[4];
#pragma unroll
                for (int ks = 0; ks < 4; ++ks) { const int s0 = ks * 32 + kq * 8; f32x4 m0, m1;
#pragma unroll
                    for (int j = 0; j < 4; ++j) { m0[j] = (s0 + j <= t) ? wq[ks][0][j] : 0.f; m1[j] = (s0 + 4 + j <= t) ? wq[ks][1][j] : 0.f; }
                    const u32x4 bw = pack8(m0, m1); bfr[ks] = *(const bf16x8*)&bw; }
                u32x2 uc[4], gc[4]; const float bt = btq;
#pragma unroll
                for (int mt = 0; mt < 4; ++mt) { uc[mt] = uq[mt]; gc[mt] = gq[mt]; }
                if (nt < 7) SGU_LOAD(nt + 1);
#pragma unroll
                for (int ks = 0; ks < 4; ++ks) if (ks <= (nt >> 1)) {
                    const int s0 = ks * 32 + kq * 8;
#pragma unroll
                    for (int mt = 0; mt < 4; ++mt) acc[mt] = mma16(ldfrag(my, mt * 16 + fr, s0), bfr[ks], acc[mt]);
                }
                const size_t tok = tok0 + t;
#pragma unroll
                for (int mt = 0; mt < 4; ++mt) { const size_t o = tok * 512 + w * 64 + mt * 16 + kq * 4;
                    const u32x2 uu = uc[mt], gg = gc[mt];
                    const float u0 = bflo(uu[0]), u1 = bfhi(uu[0]), u2 = bflo(uu[1]), u3 = bfhi(uu[1]);
                    const float g0 = bflo(gg[0]), g1 = bfhi(gg[0]), g2 = bflo(gg[1]), g3 = bfhi(gg[1]);
                    u32x2 r; r[0] = cvt_pk_bf16(geluf_(u0) * (acc[mt][0] + bt) * siluf_(g0), geluf_(u1) * (acc[mt][1] + bt) * siluf_(g1));
                    r[1] = cvt_pk_bf16(geluf_(u2) * (acc[mt][2] + bt) * siluf_(g2), geluf_(u3) * (acc[mt][3] + bt) * siluf_(g3));
                    *(u32x2*)(ubuf + o) = r; }
            }
#undef SGU_LOAD
        }
        __syncthreads();
    }
}

__device__ void phase_m2_local(const P& p, int layer, char* smem) {
    bf16_t* Cs = (bf16_t*)smem;
    bf16_t* Bs = Cs + 128 * LDP;
    bf16_t* BTs = Bs + 128 * LDP;
    bf16_t* xT = BTs + 128 * LDP;
    float* dts4 = (float*)(xT + 64 * LDP);
    float* acs4 = dts4 + 512;
    float* das4 = acs4 + 512;
    const int tid = tidx(), w = tid >> 6, lane = tid & 63, fr = lane & 15, kq = lane >> 4;
    const bf16_t* xbc = (const bf16_t*)(p.ws + OFF_XBC); const float* dtraw = (const float*)(p.ws + OFF_DTRAW);
    const float* cw = p.conv_w + (size_t)layer * 4 * 1024; const float* cbv = p.conv_b + layer * 1024;
    for (int task = bidx(); task < 256; task += gdim()) {
        const int grp = task & 1, c = (task >> 1) & 15, b = task >> 5;
        const size_t tok0 = (size_t)b * SEQ_ + c * 128;
        {
            const int h4 = tid >> 7, l = tid & 127, hd = grp * 4 + h4;
            const float aneg = -__expf(p.a_log[layer * 8 + hd]);
            const float dr = dtraw[(tok0 + l) * 8 + hd] + p.dt_bias[layer * 8 + hd]; const float e_ = __expf(dr), u_ = 1.0f + e_; const float dt = dr > 20.f ? dr : (u_ == 1.0f ? e_ : __logf(u_) * e_ * __builtin_amdgcn_rcpf(u_ - 1.0f));
            dts4[tid] = dt; das4[tid] = dt * aneg;
            float s_ = dt * aneg;
#pragma unroll
            for (int o = 1; o < 64; o <<= 1) { const float t = __shfl_up(s_, o, 64); if ((tid & 63) >= o) s_ += t; }
            __syncthreads();
            if (l >= 64) { float tot = 0.f; const float* dh = das4 + h4 * 128;
                for (int j = 0; j < 64; j += 4) tot += dh[j] + dh[j + 1] + dh[j + 2] + dh[j + 3];
                s_ += tot; }
            acs4[tid] = s_;
            ((float*)(p.ws + OFF_EACS))[(tok0 + l) * 8 + hd] = __expf(s_);
            if (l == 127) ((float*)(p.ws + OFF_ACH))[(b * 16 + c) * 8 + hd] = s_;
        }
        {
            const int cgi = tid & 31, run = tid >> 5, l0 = run * 8;
            const int ch = cgi < 16 ? 512 + grp * 128 + cgi * 8 : 768 + grp * 128 + (cgi - 16) * 8, n0 = (cgi & 15) * 8;
            f32x4 wk[4][2], bias0 = *(const f32x4*)(cbv + ch), bias1 = *(const f32x4*)(cbv + ch + 4);
#pragma unroll
            for (int k = 0; k < 4; ++k) { wk[k][0] = *(const f32x4*)(cw + k * 1024 + ch); wk[k][1] = *(const f32x4*)(cw + k * 1024 + ch + 4); }
            f32x4 h0[3], h1[3];
#pragma unroll
            for (int j = 0; j < 3; ++j) { const int l = l0 - 3 + j; const bool ok = c * 128 + l >= 0;
                u32x4 rw = *(const u32x4*)(xbc + (tok0 + (ok ? l : 0)) * 1024 + ch); if (!ok) rw = (u32x4){0u, 0u, 0u, 0u};
                unpack8(rw, h0[j], h1[j]); }
#pragma unroll 1
            for (int hb = 0; hb < 2; ++hb) {
            u32x4 raw[4];
#pragma unroll
            for (int i = 0; i < 4; ++i) raw[i] = *(const u32x4*)(xbc + (tok0 + l0 + hb * 4 + i) * 1024 + ch);
#pragma unroll
            for (int i = 0; i < 4; ++i) { const int l = l0 + hb * 4 + i;
                f32x4 c0, c1; unpack8(raw[i], c0, c1);
                f32x4 o0 = bias0 + wk[0][0] * h0[0] + wk[1][0] * h0[1] + wk[2][0] * h0[2] + wk[3][0] * c0;
                f32x4 o1 = bias1 + wk[0][1] * h1[0] + wk[1][1] * h1[1] + wk[2][1] * h1[2] + wk[3][1] * c1;
                h0[0] = h0[1]; h0[1] = h0[2]; h0[2] = c0; h1[0] = h1[1]; h1[1] = h1[2]; h1[2] = c1;
#pragma unroll
                for (int j = 0; j < 4; ++j) { o0[j] = siluf_(o0[j]); o1[j] = siluf_(o1[j]); }
                const u32x4 pk = pack8(o0, o1);
                if (cgi < 16) *(u32x4*)(Bs + l * LDP + n0) = pk;
                else { *(u32x4*)(Cs + l * LDP + n0) = pk; *(u32x4*)((bf16_t*)(p.ws + OFF_CCONV) + (tok0 + l) * 256 + grp * 128 + n0) = pk; }
            }
            }
        }
        __syncthreads();
        const int ntile = (w | 1) + 1;
        u32x2 g16[8];
        {
            f32x4 g[8];
#pragma unroll
            for (int st = 0; st < 8; ++st) g[st] = (f32x4){0.f, 0.f, 0.f, 0.f};
#pragma unroll
            for (int ks = 0; ks < 4; ++ks) { const bf16x8 a = ldfrag(Cs, w * 16 + fr, ks * 32 + kq * 8);
#pragma unroll
                for (int st = 0; st < 8; ++st) if (st < ntile) g[st] = mma16(a, ldfrag(Bs, st * 16 + fr, ks * 32 + kq * 8), g[st]); }
#pragma unroll
            for (int st = 0; st < 8; ++st) { g16[st][0] = cvt_pk_bf16(g[st][0], g[st][1]); g16[st][1] = cvt_pk_bf16(g[st][2], g[st][3]); }
        }
#pragma unroll 1
        for (int h4 = 0; h4 < 4; ++h4) {
            const int hd = grp * 4 + h4;
            const float* dts = dts4 + h4 * 128; const float* acs = acs4 + h4 * 128;
            __syncthreads();
            const float alast = acs[127];
            {
                const int cgx = tid & 7, run = tid >> 3, l0 = run * 2, ch = hd * 64 + cgx * 8, p0 = cgx * 8;
                f32x4 wk[4][2], bias0 = *(const f32x4*)(cbv + ch), bias1 = *(const f32x4*)(cbv + ch + 4);
#pragma unroll
                for (int k = 0; k < 4; ++k) { wk[k][0] = *(const f32x4*)(cw + k * 1024 + ch); wk[k][1] = *(const f32x4*)(cw + k * 1024 + ch + 4); }
                f32x4 r0[5], r1[5];
#pragma unroll
                for (int j = 0; j < 5; ++j) { const int l = l0 - 3 + j; const bool ok = c * 128 + l >= 0;
                    u32x4 rw = *(const u32x4*)(xbc + (tok0 + (ok ? l : 0)) * 1024 + ch); if (!ok) rw = (u32x4){0u, 0u, 0u, 0u};
                    unpack8(rw, r0[j], r1[j]); }
#pragma unroll
                for (int i = 0; i < 2; ++i) { const int l = l0 + i;
                    f32x4 o0 = bias0 + wk[0][0] * r0[i] + wk[1][0] * r0[i + 1] + wk[2][0] * r0[i + 2] + wk[3][0] * r0[i + 3];
                    f32x4 o1 = bias1 + wk[0][1] * r1[i] + wk[1][1] * r1[i + 1] + wk[2][1] * r1[i + 2] + wk[3][1] * r1[i + 3];
#pragma unroll
                    for (int j = 0; j < 4; ++j) { xT[(p0 + j) * LDP + l] = f2bf(siluf_(o0[j])); xT[(p0 + 4 + j) * LDP + l] = f2bf(siluf_(o1[j])); } }
            }
#pragma unroll
            for (int i = 0; i < 4; ++i) { const int pr = tid + i * 512, l = pr & 127, n0 = (pr >> 7) * 8;
                f32x4 b0, b1; unpack8(*(const u32x4*)(Bs + l * LDP + n0), b0, b1);
                const float sc = dts[l] * __expf(alast - acs[l]);
#pragma unroll
                for (int j = 0; j < 4; ++j) { BTs[(n0 + j) * LDP + l] = f2bf(b0[j] * sc); BTs[(n0 + 4 + j) * LDP + l] = f2bf(b1[j] * sc); } }
#pragma unroll
            for (int st = 0; st < 8; ++st) if (st < ntile) { const int s_ = st * 16 + fr; const float as_ = acs[s_], ds_ = dts[s_];
#pragma unroll
                for (int r = 0; r < 4; ++r) { const int l = w * 16 + kq * 4 + r; const float gv = (r & 1) ? bfhi(g16[st][r >> 1]) : bflo(g16[st][r >> 1]); const float v = (s_ <= l) ? gv * __expf(acs[l] - as_) * ds_ : 0.f; Cs[l * LDP + s_] = f2bf(v); } }
            __syncthreads();
            {
                f32x4 y[4];
#pragma unroll
                for (int mt = 0; mt < 4; ++mt) y[mt] = (f32x4){0.f, 0.f, 0.f, 0.f};
                for (int ks = 0; ks <= (w >> 1); ++ks) { const bf16x8 bfrag = ldfrag(Cs, w * 16 + fr, ks * 32 + kq * 8);
#pragma unroll
                    for (int mt = 0; mt < 4; ++mt) y[mt] = mma16(ldfrag(xT, mt * 16 + fr, ks * 32 + kq * 8), bfrag, y[mt]); }
                const int l = w * 16 + fr; const float dd = p.m2_d[layer * 8 + hd];
                bf16_t* yp = (bf16_t*)(p.ws + OFF_YPART) + (tok0 + l) * 512 + hd * 64;
#pragma unroll
                for (int mt = 0; mt < 4; ++mt) { const int p0 = mt * 16 + kq * 4; f32x4 v;
#pragma unroll
                    for (int r = 0; r < 4; ++r) v[r] = y[mt][r] + dd * bf2f(xT[(p0 + r) * LDP + l]);
                    u32x2 o; o[0] = cvt_pk_bf16(v[0], v[1]); o[1] = cvt_pk_bf16(v[2], v[3]); *(u32x2*)(yp + p0) = o; }
            }
            {
                f32x4 st_[4];
#pragma unroll
                for (int pt = 0; pt < 4; ++pt) st_[pt] = (f32x4){0.f, 0.f, 0.f, 0.f};
#pragma unroll
                for (int ks = 0; ks < 4; ++ks) { const bf16x8 a = ldfrag(BTs, w * 16 + fr, ks * 32 + kq * 8);
#pragma unroll
                    for (int pt = 0; pt < 4; ++pt) st_[pt] = mma16(a, ldfrag(xT, pt * 16 + fr, ks * 32 + kq * 8), st_[pt]); }
                bf16_t* sb = (bf16_t*)(p.ws + OFF_M2ST) + (size_t)((b * 16 + c) * 8 + hd) * 64 * 128;
#pragma unroll
                for (int pt = 0; pt < 4; ++pt) { const int pp = pt * 16 + fr, n0 = w * 16 + kq * 4;
                    u32x2 o; o[0] = cvt_pk_bf16(st_[pt][0], st_[pt][1]); o[1] = cvt_pk_bf16(st_[pt][2], st_[pt][3]); *(u32x2*)(sb + pp * 128 + n0) = o; }
            }
        }
        __syncthreads();
    }
}

__device__ void phase_m2_carry(const P& p) {
    const int tid = tidx();
    for (int idx = bidx() * 512 + tid; idx < 8 * 8 * 64 * 32; idx += gdim() * 512) {
        const int n4 = idx & 31, pp = (idx >> 5) & 63, hd = (idx >> 11) & 7, b = idx >> 14;
        bf16_t* base = (bf16_t*)(p.ws + OFF_M2ST) + (size_t)(b * 16 * 8 + hd) * 8192 + pp * 128 + n4 * 4;
        const float* ach = (const float*)(p.ws + OFF_ACH) + b * 16 * 8 + hd;
        u32x2 ld[16];
#pragma unroll
        for (int c = 0; c < 16; ++c) ld[c] = *(const u32x2*)(base + (size_t)c * 8 * 8192);
        float decq[16];
#pragma unroll
        for (int c = 0; c < 16; ++c) decq[c] = ach[c * 8];
        f32x4 S = (f32x4){0.f, 0.f, 0.f, 0.f};
#pragma unroll
        for (int c = 0; c < 16; ++c) { u32x2 o; o[0] = cvt_pk_bf16(S[0], S[1]); o[1] = cvt_pk_bf16(S[2], S[3]); *(u32x2*)(base + (size_t)c * 8 * 8192) = o;
            const float dec = __expf(decq[c]);
            S[0] = dec * S[0] + bflo(ld[c][0]); S[1] = dec * S[1] + bfhi(ld[c][0]); S[2] = dec * S[2] + bflo(ld[c][1]); S[3] = dec * S[3] + bfhi(ld[c][1]); }
    }
}
__device__ void s5_carry_unit(const P& p, char* smem, int g, int pm) {
    const int tid = tidx();
    float* ex = (float*)(smem + 65536);
    const bf16_t* sloc = (const bf16_t*)smem;
    __syncthreads();
    for (int bb = 0; bb < 2; ++bb) {
        const int b = pm * 2 + bb, n = tid & 63, seg = tid >> 6;
        const float aqr = ((const float*)(p.ws + OFF_AQ))[(g * 64 + n) * 2], aqi = ((const float*)(p.ws + OFF_AQ))[(g * 64 + n) * 2 + 1];
        const bf16_t* sl = sloc + (bb * 128 + seg * 16) * 128;
        bf16_t* a2 = (bf16_t*)(p.ws + OFF_A2) + ((size_t)g * 1024 + b * 128 + seg * 16) * 384;
        float lr[16], li[16];
#pragma unroll
        for (int j = 0; j < 16; ++j) { lr[j] = bf2f(sl[j * 128 + n]); li[j] = bf2f(sl[j * 128 + 64 + n]); }
        float sr = 0.f, si = 0.f;
#pragma unroll
        for (int j = 0; j < 16; ++j) { const float t0 = aqr * sr - aqi * si + lr[j], t1 = aqr * si + aqi * sr + li[j]; sr = t0; si = t1; }
        __syncthreads();
        ex[(seg * 64 + n) * 2] = sr; ex[(seg * 64 + n) * 2 + 1] = si;
        __syncthreads();
        float pr = aqr, pi = aqi;
#pragma unroll
        for (int j = 0; j < 4; ++j) { const float t0 = pr * pr - pi * pi, t1 = 2.f * pr * pi; pr = t0; pi = t1; }
        float cr_ = 0.f, ci_ = 0.f;
        for (int s_ = 0; s_ < seg; ++s_) { const float er = ex[(s_ * 64 + n) * 2], ei = ex[(s_ * 64 + n) * 2 + 1]; const float t0 = pr * cr_ - pi * ci_ + er, t1 = pr * ci_ + pi * cr_ + ei; cr_ = t0; ci_ = t1; }
        sr = cr_; si = ci_;
#pragma unroll
        for (int j = 0; j < 16; ++j) { a2[j * 384 + n] = f2bf(sr); a2[j * 384 + 64 + n] = f2bf(si);
            const float t0 = aqr * sr - aqi * si + lr[j], t1 = aqr * si + aqi * sr + li[j]; sr = t0; si = t1; }
    }
    asm volatile("s_waitcnt vmcnt(0)" ::: "memory");
    __syncthreads();
}

__device__ void phase_m2_out(const P& p, int layer, char* smem) {
    float* ssq = (float*)smem;
    float* rst = ssq + 512;
    const int tid = tidx(), w = tid >> 6, lane = tid & 63, fr = lane & 15, kq = lane >> 4, grp = w >> 2;
    const bf16_t* cc = (const bf16_t*)(p.ws + OFF_CCONV); const bf16_t* yp = (const bf16_t*)(p.ws + OFF_YPART); bf16_t* zb = (bf16_t*)(p.ws + OFF_M2Z);
    const float* eacs = (const float*)(p.ws + OFF_EACS); const float* nw = p.m2_norm_w + layer * 512 + w * 64;
    for (int task = bidx(); task < 256; task += gdim()) {
        const int half = task & 1, c = (task >> 1) & 15, b = task >> 5;
        const size_t tok0 = (size_t)b * SEQ_ + c * 128 + half * 64;
        const bf16_t* sin_ = (const bf16_t*)(p.ws + OFF_M2ST) + (size_t)((b * 16 + c) * 8 + w) * 8192;
        f32x4 acc[4][4];
#pragma unroll
        for (int mt = 0; mt < 4; ++mt)
#pragma unroll
            for (int nt = 0; nt < 4; ++nt) acc[mt][nt] = (f32x4){0.f, 0.f, 0.f, 0.f};
#pragma unroll
        for (int ks = 0; ks < 4; ++ks) { bf16x8 a[4];
#pragma unroll
            for (int mt = 0; mt < 4; ++mt) a[mt] = *(const bf16x8*)(sin_ + (mt * 16 + fr) * 128 + ks * 32 + kq * 8);
#pragma unroll
            for (int nt = 0; nt < 4; ++nt) { const bf16x8 bb = *(const bf16x8*)(cc + (tok0 + nt * 16 + fr) * 256 + grp * 128 + ks * 32 + kq * 8);
#pragma unroll
                for (int mt = 0; mt < 4; ++mt) acc[mt][nt] = mma16(a[mt], bb, acc[mt][nt]); } }
        u32x2 yq[4][4], zq[4][4]; float eaq[4];
#pragma unroll
        for (int nt = 0; nt < 4; ++nt) { const size_t tok = tok0 + nt * 16 + fr; eaq[nt] = eacs[tok * 8 + w];
#pragma unroll
            for (int mt = 0; mt < 4; ++mt) { const size_t o = tok * 512 + w * 64 + mt * 16 + kq * 4; yq[nt][mt] = *(const u32x2*)(yp + o); zq[nt][mt] = *(const u32x2*)(zb + o); } }
#pragma unroll
        for (int nt = 0; nt < 4; ++nt) { const float ea = eaq[nt]; float ss = 0.f;
#pragma unroll
            for (int mt = 0; mt < 4; ++mt) {
                const u32x2 yy = yq[nt][mt], zz = zq[nt][mt];
                f32x4 v; v[0] = (bflo(yy[0]) + ea * acc[mt][nt][0]) * siluf_(bflo(zz[0])); v[1] = (bfhi(yy[0]) + ea * acc[mt][nt][1]) * siluf_(bfhi(zz[0]));
                v[2] = (bflo(yy[1]) + ea * acc[mt][nt][2]) * siluf_(bflo(zz[1])); v[3] = (bfhi(yy[1]) + ea * acc[mt][nt][3]) * siluf_(bfhi(zz[1]));
                acc[mt][nt] = v; ss += v[0] * v[0] + v[1] * v[1] + v[2] * v[2] + v[3] * v[3]; }
            ss += __shfl_xor(ss, 16, 64); ss += __shfl_xor(ss, 32, 64);
            if (kq == 0) ssq[w * 64 + nt * 16 + fr] = ss; }
        __syncthreads();
        if (tid < 64) { float s = 0.f;
#pragma unroll
            for (int hh = 0; hh < 8; ++hh) s += ssq[hh * 64 + tid];
            rst[tid] = rsqrtf(s * (1.0f / 512.0f) + 1e-6f); }
        __syncthreads();
        f32x4 wvn[4];
#pragma unroll
        for (int mt = 0; mt < 4; ++mt) wvn[mt] = *(const f32x4*)(nw + mt * 16 + kq * 4);
#pragma unroll
        for (int nt = 0; nt < 4; ++nt) { const size_t tok = tok0 + nt * 16 + fr; const float r = rst[nt * 16 + fr];
#pragma unroll
            for (int mt = 0; mt < 4; ++mt) { const int p0 = mt * 16 + kq * 4; const f32x4 v = acc[mt][nt] * r * wvn[mt];
                u32x2 o; o[0] = cvt_pk_bf16(v[0], v[1]); o[1] = cvt_pk_bf16(v[2], v[3]); *(u32x2*)(zb + tok * 512 + w * 64 + p0) = o; } }
        __syncthreads();
    }
}

__device__ __forceinline__ void phase_shortconv(const P& p, int layer, int vb, int nvb) {
    const bf16_t* cb = (const bf16_t*)(p.ws + OFF_SCC); const bf16_t* hb = (const bf16_t*)(p.ws + OFF_SCH); const bf16_t* gb = (const bf16_t*)(p.ws + OFF_SCG); bf16_t* bb = (bf16_t*)(p.ws + OFF_SCB);
    const float* cw = p.sc_w + (size_t)layer * 3 * 512;
    for (int idx = vb * 512 + tidx(); idx < (T_ / 8) * 64; idx += nvb * 512) {
        const int cgp = idx & 63, run = idx >> 6, ch = cgp * 8; const size_t t0 = (size_t)run * 8; const int lseq = (int)(t0 & (SEQ_ - 1));
        f32x4 w0[3], w1[3];
#pragma unroll
        for (int k = 0; k < 3; ++k) { w0[k] = *(const f32x4*)(cw + k * 512 + ch); w1[k] = *(const f32x4*)(cw + k * 512 + ch + 4); }
        f32x4 pa0[2], pa1[2];
#pragma unroll
        for (int j = 0; j < 2; ++j) { const bool ok = lseq - 2 + j >= 0; const size_t o = (ok ? t0 - 2 + j : t0) * 512 + ch;
            u32x4 wc_ = *(const u32x4*)(cb + o), wh_ = *(const u32x4*)(hb + o); if (!ok) { wc_ = (u32x4){0u, 0u, 0u, 0u}; wh_ = wc_; }
            f32x4 c0, c1, h0, h1; unpack8(wc_, c0, c1); unpack8(wh_, h0, h1); pa0[j] = c0 * h0; pa1[j] = c1 * h1; }
#pragma unroll
        for (int hbt = 0; hbt < 2; ++hbt) {
            u32x4 rc[4], rh[4], rb[4], rg[4];
#pragma unroll
            for (int i = 0; i < 4; ++i) { const size_t o = (t0 + hbt * 4 + i) * 512 + ch; rc[i] = *(const u32x4*)(cb + o); rh[i] = *(const u32x4*)(hb + o); rb[i] = *(const u32x4*)(bb + o); rg[i] = *(const u32x4*)(gb + o); }
#pragma unroll
            for (int i = 0; i < 4; ++i) { const size_t o = (t0 + hbt * 4 + i) * 512 + ch;
                f32x4 c0, c1, h0, h1, b0, b1, g0, g1; unpack8(rc[i], c0, c1); unpack8(rh[i], h0, h1); unpack8(rb[i], b0, b1); unpack8(rg[i], g0, g1);
                const f32x4 q0 = c0 * h0, q1 = c1 * h1;
                f32x4 y0 = b0 * (w0[0] * pa0[0] + w0[1] * pa0[1] + w0[2] * q0), y1 = b1 * (w1[0] * pa1[0] + w1[1] * pa1[1] + w1[2] * q1);
#pragma unroll
                for (int j = 0; j < 4; ++j) { y0[j] *= siluf_(g0[j]); y1[j] *= siluf_(g1[j]); }
                *(u32x4*)(bb + o) = pack8(y0, y1);
                pa0[0] = pa0[1]; pa0[1] = q0; pa1[0] = pa1[1]; pa1[1] = q1; }
        }
    }
}

#define XB_TMO      128
#define XB_XCNT(j)  (256  + 64 * (j))
#define XB_XSUB(j)  (1280 + 64 * (j))
#define XB_XGEN(j)  (2304 + 64 * (j))
#define XB_TOP      3328
#define XB_TOPGEN   3392
#define XCD_BAR_WORDS 3456
#define XB_SPIN_CAP (1u << 20)
__device__ __forceinline__ unsigned xb_ld(unsigned* p)              { return __hip_atomic_load(p, __ATOMIC_RELAXED, __HIP_MEMORY_SCOPE_AGENT); }
__device__ __forceinline__ unsigned xb_add(unsigned* p, unsigned v) { return __hip_atomic_fetch_add(p, v, __ATOMIC_RELAXED, __HIP_MEMORY_SCOPE_AGENT); }
__device__ __forceinline__ unsigned xb_xcc_id() { return (unsigned)__builtin_amdgcn_s_getreg((3 << 11) | 20) & 0xFu; }
#define XB_SPIN(cond, bar) do { unsigned _sp = 0; while (cond) { __builtin_amdgcn_s_sleep(1); \
    if ((++_sp & 255u) == 0u) { if (xb_ld(&(bar)[XB_TMO])) break; if (_sp > XB_SPIN_CAP) { atomicAdd(&(bar)[XB_TMO], 1u); break; } } } } while (0)
struct XcdBarrier { unsigned* bar; unsigned x; volatile LAS unsigned* st; };
__device__ __forceinline__ XcdBarrier xcd_barrier_post(unsigned* bar, volatile LAS unsigned* st) {
    XcdBarrier b; b.bar = bar; b.x = xb_xcc_id(); b.st = st;
    if (__builtin_amdgcn_workitem_id_x() == 0) (void)xb_add(&bar[XB_XCNT(b.x)], 1u);
    return b;
}
__device__ __forceinline__ void xcd_barrier_complete(unsigned* bar, unsigned x, unsigned& nloc, unsigned& nx) {
    const unsigned G = (unsigned)gdim();
    unsigned sum, cnt, mine, sp = 0u;
    for (;;) {
        sum = 0u; cnt = 0u; mine = 0u;
        unsigned cv[16];
#pragma unroll
        for (unsigned j = 0; j < 16; ++j) cv[j] = xb_ld(&bar[XB_XCNT(j)]);
#pragma unroll
        for (unsigned j = 0; j < 16; ++j) { const unsigned c = cv[j]; sum += c; cnt += (c > 0u) ? 1u : 0u; mine = (j == x) ? c : mine; }
        if (sum == G) break;
        __builtin_amdgcn_s_sleep(1);
        if ((++sp & 255u) == 0u) { if (xb_ld(&bar[XB_TMO])) break; if (sp > XB_SPIN_CAP) { atomicAdd(&bar[XB_TMO], 1u); break; } }
    }
    nloc = mine > 0u ? mine : 1u; nx = cnt > 0u ? cnt : 1u;
}
__device__ __forceinline__ void xcd_barrier(const XcdBarrier& b) {
    asm volatile("s_waitcnt vmcnt(0)" ::: "memory");
    __syncthreads();
    if (__builtin_amdgcn_workitem_id_x() == 0) {
        unsigned* bar = b.bar;
        __builtin_amdgcn_s_waitcnt(0);
        unsigned nloc = b.st[0], nx = b.st[1];
        if (nloc == 0u) { xcd_barrier_complete(bar, b.x, nloc, nx); b.st[0] = nloc; b.st[1] = nx; }
        const unsigned old = xb_add(&bar[XB_XSUB(b.x)], 1u);
        const unsigned gen = old / nloc;
        if (old + 1u == (gen + 1u) * nloc) {
            __builtin_amdgcn_fence(__ATOMIC_RELEASE, "agent");
            asm volatile("s_waitcnt vmcnt(0)" ::: "memory");
            const unsigned og = xb_add(&bar[XB_TOP], 1u);
            const unsigned tg = og / nx;
            if (og + 1u == (tg + 1u) * nx) xb_add(&bar[XB_TOPGEN], 1u);
            else XB_SPIN(xb_ld(&bar[XB_TOPGEN]) == tg, bar);
            __builtin_amdgcn_fence(__ATOMIC_ACQUIRE, "agent");
            xb_add(&bar[XB_XGEN(b.x)], 1u);
            asm volatile("s_waitcnt vmcnt(0)" ::: "memory");
        } else {
            XB_SPIN(xb_ld(&bar[XB_XGEN(b.x)]) == gen, bar);
            __builtin_amdgcn_fence(__ATOMIC_ACQUIRE, "agent");
            asm volatile("s_waitcnt vmcnt(0)" ::: "memory");
        }
    }
    __syncthreads();
}


template <int PH> __device__ __forceinline__ void run_phase(const P& p, int layer, char* smem) {
    LAS unsigned char* lds = (LAS unsigned char*)smem;
    const int G = gdim(), c = bidx();
    const float* xin = layer == 0 ? p.x : p.out;
    if (PH == 0) { phase_prep_weights(p, layer, smem); phase_s5_tables(p, layer, smem); phase_rmsnorm_h(p, layer, xin, smem); }
    if (PH == 1) { SchedG1 S{p.ws + OFF_H, p.ws + OFF_WINT, G, c}; EpiG1 E{p.ws}; gemm_phase(lds, S, E); }
    if (PH == 2) {
        for (int L = c; L < 128; L += G) {
            { SchedS1 S{p.ws, 128, L}; EpiS1 E{}; gemm_phase(lds, S, E); }
            s5_carry_unit(p, smem, L >> 2, L & 3);
            { SchedS2 S{p.ws, 128, L}; EpiS2 E{p.ws, p.s5_d + layer * 512}; gemm_phase(lds, S, E); }
        }
        phase_sgu(p, layer, smem, (c + G - (128 % G)) % G, G); phase_m2_local(p, layer, smem); }
    if (PH == 3) { phase_m2_carry(p); { SchedGLU S{p.ws, G, c}; EpiGLU E{p.ws}; gemm_phase(lds, S, E); }
        { const bool split = G > 128; const int vb = split ? c - 128 : c, nvb = split ? G - 128 : G; if (vb >= 0) phase_shortconv(p, layer, vb, nvb); } }
    if (PH == 4) { phase_m2_out(p, layer, smem); }
    if (PH == 6) { SchedP3 S{p.ws, G, c}; EpiP3 E{p.ws, p.merge_b + layer * 4096}; gemm_phase(lds, S, E); }
    if (PH == 7) { SchedP4 S{p.ws, G, c}; EpiP4 E{xin, p.out}; gemm_phase(lds, S, E); }
    if (PH == 8) { phase_final_norm(p); }
}

template <int PH> __global__ void __launch_bounds__(512, 2) k_phase(P p, int layer) {
    extern __shared__ __attribute__((aligned(16))) char smem[];
    run_phase<PH>(p, layer, smem);
}

#if MEGA
__global__ void __launch_bounds__(512, 2) k_mega(P p) {
    extern __shared__ __attribute__((aligned(16))) char smem[];
    cg::grid_group grid = cg::this_grid();
    if (p.ws == nullptr) grid.sync();
    volatile LAS unsigned* xbw = (volatile LAS unsigned*)(LAS unsigned char*)(smem + SMEM_BYTES - 16);
    if (__builtin_amdgcn_workitem_id_x() == 0) { xbw[0] = 0u; xbw[1] = 0u;
        const unsigned xcc = xb_xcc_id(), rank = xb_add((unsigned*)(p.ws + OFF_BAR) + 4 * xcc, 1u);
        xbw[2] = (unsigned)__builtin_amdgcn_workgroup_id_x();
        xbw[3] = rank * 8u + xcc; }
    __syncthreads();
    const XcdBarrier xb = xcd_barrier_post((unsigned*)(p.ws + OFF_BAR), xbw);
    for (int step = 0; step < 15; ++step) {
        P q = p;
        asm volatile("" : "+s"(q.ws), "+s"(q.out), "+s"(q.x));
        int layer = __builtin_amdgcn_readfirstlane(step / 7); const int ph = step - 7 * layer;
        asm volatile("" : "+s"(layer));
        if (step == 14) { run_phase<8>(q, 0, smem); break; }
        switch (ph) {
            case 0: run_phase<0>(q, layer, smem); break;
            case 1: run_phase<1>(q, layer, smem); break;
            case 2: run_phase<2>(q, layer, smem); break;
            case 3: run_phase<3>(q, layer, smem); break;
            case 4: run_phase<4>(q, layer, smem); break;
            case 5: run_phase<6>(q, layer, smem); break;
            default: run_phase<7>(q, layer, smem); break;
        }
        xcd_barrier(xb);
        if (step == 0) {
            if (__builtin_amdgcn_workitem_id_x() == 0) { bool ok = gdim() == 256;
                unsigned cv[16];
#pragma unroll
                for (unsigned j = 0; j < 16; ++j) cv[j] = xb_ld((unsigned*)(p.ws + OFF_BAR) + XB_XCNT(j));
#pragma unroll
                for (unsigned j = 0; j < 16; ++j) ok = ok && (cv[j] == (j < 8u ? 32u : 0u));
                if (ok) xbw[2] = xbw[3]; }
            __syncthreads();
        }
    }
}
#endif

template <int PH> static void launch_phase(const P& p, int layer, hipStream_t stream) {
    static bool attr = false;
    if (!attr) { hipFuncSetAttribute((const void*)k_phase<PH>, hipFuncAttributeMaxDynamicSharedMemorySize, SMEM_BYTES); attr = true; }
    hipLaunchKernelGGL(k_phase<PH>, dim3(256), dim3(512), SMEM_BYTES, stream, p, layer);
}

extern "C" void kernel_launch(void* const* d_in, const int* in_sizes, int n_in, void* d_out, int out_size, void* d_ws, size_t ws_size, hipStream_t stream) {
    if (ws_size < WS_NEED) { fprintf(stderr, "workspace too small: %zu < %zu\n", ws_size, (size_t)WS_NEED); return; }
    P p{};
    const float** f = (const float**)&p;
    for (int i = 0; i < 27; ++i) f[i] = (const float*)d_in[i];
    p.out = (float*)d_out; p.ws = (char*)d_ws;
#if MEGA
    static int grid_blocks = 0;
    if (!grid_blocks) {
        hipFuncSetAttribute((const void*)k_mega, hipFuncAttributeMaxDynamicSharedMemorySize, SMEM_BYTES);
        int dev = 0, cus = 0, per_cu = 0; hipGetDevice(&dev); hipDeviceGetAttribute(&cus, hipDeviceAttributeMultiprocessorCount, dev);
        hipOccupancyMaxActiveBlocksPerMultiprocessor(&per_cu, k_mega, 512, SMEM_BYTES);
        if (per_cu > 1) per_cu = 1;
        grid_blocks = cus * per_cu;
    }
    (void)hipMemsetAsync((char*)d_ws + OFF_BAR, 0, XCD_BAR_WORDS * 4, stream);
    void* args[] = {&p};
    hipError_t e = hipLaunchCooperativeKernel((const void*)k_mega, dim3(grid_blocks), dim3(512), args, SMEM_BYTES, stream);
    if (e != hipSuccess) fprintf(stderr, "cooperative launch failed: %s (grid %d)\n", hipGetErrorString(e), grid_blocks);
#else
    for (int layer = 0; layer < 2; ++layer) {
#define LP(ph) do { launch_phase<ph>(p, layer, stream); if (PROBE_PH == ph) { launch_phase<ph>(p, layer, stream); launch_phase<ph>(p, layer, stream); } } while (0)
        LP(0); LP(1); LP(2); LP(3); LP(4); LP(6); LP(7);
    }
    launch_phase<8>(p, 0, stream);
#endif
}
```

```cpp
#include <hip/hip_runtime.h>
#include <hip/hip_cooperative_groups.h>
#include <cstdio>
namespace cg = cooperative_groups;

#ifndef MEGA
#define MEGA 1
#endif
#ifndef PROBE_PH
#define PROBE_PH -1
#endif
#ifndef PROBE_SUB
#define PROBE_SUB 0
#endif

#define LAS __attribute__((address_space(3)))
typedef unsigned short bf16_t;
typedef short bf16x8 __attribute__((ext_vector_type(8)));
typedef float f32x4 __attribute__((ext_vector_type(4)));
typedef float f32x2 __attribute__((ext_vector_type(2)));
typedef unsigned u32x4 __attribute__((ext_vector_type(4)));
typedef unsigned u32x2 __attribute__((ext_vector_type(2)));

constexpr int SMEM_BYTES = 150528;
#define VBID_LDS_OFF (SMEM_BYTES - 8)
constexpr int T_ = 16384, D_ = 1024, W_ = 512, SEQ_ = 2048;
constexpr int IN_DIM_ = 10248;
constexpr size_t MiB = 1048576;
constexpr size_t OFF_WINT = 0, OFF_WBT = 20 * MiB, OFF_WOUTT = 24 * MiB, OFF_WGLUT = 26 * MiB, OFF_DTRAW = 26 * MiB + MiB / 2,
                 OFF_H = 27 * MiB, OFF_A2 = 59 * MiB, OFF_S5G = 83 * MiB, OFF_SGUU = 99 * MiB, OFF_M2Z = 115 * MiB, OFF_SCB = 131 * MiB,
                 OFF_SGUV = 147 * MiB, OFF_SGUG = 163 * MiB, OFF_XBC = 179 * MiB, OFF_SCC = 211 * MiB, OFF_SCH = 227 * MiB, OFF_SCG = 243 * MiB,
                 OFF_B2TAB = 259 * MiB, OFF_GTAB = 265 * MiB, OFF_YS5 = 267 * MiB + MiB / 4, OFF_M2ST = 283 * MiB + MiB / 4,
                 OFF_YPART = 299 * MiB + MiB / 4, OFF_EACS = 315 * MiB + MiB / 4, OFF_ACH = 315 * MiB + 3 * MiB / 4, OFF_AQ = 315 * MiB + 7 * MiB / 8,
                 OFF_BAR = 316 * MiB, WS_NEED = 316 * MiB + 16384;
constexpr size_t OFF_CCONV = 0;
constexpr size_t OFF_MERGED = OFF_XBC, OFF_GS = OFF_SCC, OFF_PART = OFF_SCG;

struct P {
    const float *x, *norm_w, *w_in, *lam_re, *lam_im, *b_re, *b_im, *c_re, *c_im, *s5_d, *log_step, *w_glu, *ln_w, *ln_b, *sgu_w, *sgu_b,
        *conv_w, *conv_b, *dt_bias, *a_log, *m2_d, *m2_norm_w, *sc_w, *merge_b, *w_branch, *w_out, *final_w;
    float* out;
    char* ws;
};

typedef __bf16 bf16v2 __attribute__((ext_vector_type(2)));
__device__ __forceinline__ unsigned cvt_pk_bf16(float lo, float hi) { const f32x2 v = {lo, hi}; const bf16v2 b = __builtin_convertvector(v, bf16v2); return __builtin_bit_cast(unsigned, b); }
__device__ __forceinline__ int tidx() { int t = __builtin_amdgcn_workitem_id_x(); asm volatile("" : "+v"(t)); return t; }
#if MEGA
__device__ __forceinline__ int bidx() { int t = (int)*(volatile LAS unsigned*)(VBID_LDS_OFF); t = __builtin_amdgcn_readfirstlane(t); asm volatile("" : "+s"(t)); return t; }
#else
__device__ __forceinline__ int bidx() { int t = __builtin_amdgcn_workgroup_id_x(); asm volatile("" : "+s"(t)); return t; }
#endif
__device__ __forceinline__ int gdim() { int t = (int)__builtin_amdgcn_grid_size_x() / (int)__builtin_amdgcn_workgroup_size_x(); asm volatile("" : "+s"(t)); return t; }
__device__ __forceinline__ bf16_t f2bf(float f) { return (bf16_t)(cvt_pk_bf16(f, 0.f) & 0xffffu); }
__device__ __forceinline__ float bf2f(unsigned b) { return __uint_as_float(b << 16); }
__device__ __forceinline__ float bflo(unsigned w) { return __uint_as_float(w << 16); }
__device__ __forceinline__ float bfhi(unsigned w) { return __uint_as_float(w & 0xffff0000u); }
__device__ __forceinline__ float sigmoidf_(float z) { return __builtin_amdgcn_rcpf(1.0f + __expf(-z)); }
__device__ __forceinline__ float siluf_(float z) { return z * sigmoidf_(z); }
__device__ __forceinline__ float geluf_(float v) { const float z = 1.5957691216f * (v + 0.044715f * v * v * v); return v * sigmoidf_(z); }
__device__ __forceinline__ u32x4 pack8(const f32x4 a, const f32x4 b) { u32x4 r; r[0] = cvt_pk_bf16(a[0], a[1]); r[1] = cvt_pk_bf16(a[2], a[3]); r[2] = cvt_pk_bf16(b[0], b[1]); r[3] = cvt_pk_bf16(b[2], b[3]); return r; }
__device__ __forceinline__ void unpack8(const u32x4 r, f32x4& a, f32x4& b) { a[0] = bflo(r[0]); a[1] = bfhi(r[0]); a[2] = bflo(r[1]); a[3] = bfhi(r[1]); b[0] = bflo(r[2]); b[1] = bfhi(r[2]); b[2] = bflo(r[3]); b[3] = bfhi(r[3]); }

constexpr int BM = 256, BK = 64, HALF = 128, HTB = HALF * BK * 2, STAGE_BYTES = 8 * HTB;
__device__ __forceinline__ int lds_byte(int r, int c) { const int st = (r >> 4) * 2 + (c >> 5), rr = r & 15, cc = c & 31, ob = rr * 64 + cc * 2; return st * 1024 + (ob ^ (((ob >> 9) & 1) << 5)); }
__device__ __forceinline__ void stage_rc(int b, int& R, int& C) { const int st = b / 1024, sb = b % 1024, swz = sb ^ (((sb >> 9) & 1) << 5); R = (st >> 1) * 16 + swz / 64; C = (st & 1) * 32 + (swz % 64) / 2; }
__device__ __forceinline__ int perm32(int rho) { const int n = rho >> 4, i = rho & 15; return 8 * (i >> 2) + 4 * n + (i & 3); }

struct Unit { const char* A; const char* B; unsigned lda2, ldb2; int nt, tag, pm, pn; };

template <class Epi, class Sched>
__device__ __forceinline__ void gemm_phase(LAS unsigned char* lds, const Sched& S, const Epi& E) {
    const int tid = tidx(), wid = __builtin_amdgcn_readfirstlane(tid >> 6), lane = tid & 63, wr = wid >> 2, wc = wid & 3, fr = lane & 15, fq = lane >> 4;
    unsigned pkR = 0u, pkC = 0u;
#pragma unroll
    for (int i = 0; i < 2; ++i) { int R, C; stage_rc(tid * 16 + i * 8192, R, C); pkR |= ((unsigned)R << (8 * i)) | ((unsigned)((R & ~31) + perm32(R & 31)) << (16 + 8 * i)); pkC |= ((unsigned)C * 2u) << (8 * i); }
#define RA 0
#define RB 16
    const size_t kstep = (size_t)(BK * 2);
    const unsigned ldsw = (unsigned)wid * 1024u;
    const int aoff = lds_byte(wr * 64 + fr, fq * 8), boff = lds_byte(wc * 32 + fr, fq * 8);
#define G_SA(b, h) (((b) * 2 + (h)) * HTB)
#define G_SB(b, h) ((4 + (b) * 2 + (h)) * HTB)
#define G_STAGE(bufoff, gbase, ld2, hf, RV) do { _Pragma("unroll") for (int _i = 0; _i < 2; ++_i) \
        __builtin_amdgcn_global_load_lds((const unsigned*)((const char*)(gbase) + (size_t)(((unsigned)(hf) * HALF + ((pkR >> (RV + 8 * _i)) & 0xffu)) * (ld2) + ((pkC >> (8 * _i)) & 0xffu))), (LAS unsigned*)(lds + (bufoff) + ldsw + _i * 8192), 16, 0, 0); } while (0)
#define G_LDA(dst, b, h) do { _Pragma("unroll") for (int m = 0; m < 4; ++m) _Pragma("unroll") for (int k = 0; k < 2; ++k) dst[m][k] = *(const LAS bf16x8*)(lds + G_SA(b, h) + aoff + m * 2048 + k * 1024); } while (0)
#define G_LDB(dst, b, h) do { _Pragma("unroll") for (int n = 0; n < 2; ++n) _Pragma("unroll") for (int k = 0; k < 2; ++k) dst[n][k] = *(const LAS bf16x8*)(lds + G_SB(b, h) + boff + n * 2048 + k * 1024); } while (0)
#define G_MMA(ai, bj, At, Bt) do { __builtin_amdgcn_s_setprio(1); _Pragma("unroll") for (int m = 0; m < 4; ++m) _Pragma("unroll") for (int n = 0; n < 2; ++n) _Pragma("unroll") for (int k = 0; k < 2; ++k) \
        acc[ai][bj][m][n] = __builtin_amdgcn_mfma_f32_16x16x32_bf16(Bt[n][k], At[m][k], acc[ai][bj][m][n], 0, 0, 0); __builtin_amdgcn_s_setprio(0); } while (0)
#define G_WAIT_V(n) asm volatile("s_waitcnt vmcnt(" #n ")" ::: "memory")
#define G_WAIT_L(n) asm volatile("s_waitcnt lgkmcnt(" #n ")" ::: "memory")
#define G_BAR __builtin_amdgcn_s_barrier()
#define G_SCHED __builtin_amdgcn_sched_barrier(0)
    Unit cur, nxt; int ui = 0;
    if (!S.next(0, cur)) return;
    f32x4 acc[2][2][4][2];
#pragma unroll
    for (int a = 0; a < 2; ++a)
#pragma unroll
        for (int b = 0; b < 2; ++b)
#pragma unroll
            for (int m = 0; m < 4; ++m)
#pragma unroll
                for (int n = 0; n < 2; ++n) acc[a][b][m][n] = (f32x4){0.f, 0.f, 0.f, 0.f};
    bf16x8 At[4][2], B0[2][2], B1[2][2];
    const char* cA = cur.A; const char* cB = cur.B; unsigned cla = cur.lda2, clb = cur.ldb2;
    G_STAGE(G_SB(0, 0), cB, clb, 0, RB); G_STAGE(G_SA(0, 0), cA, cla, 0, RA); G_STAGE(G_SB(0, 1), cB, clb, 1, RB); G_STAGE(G_SA(0, 1), cA, cla, 1, RA);
    if (wr == 1) G_BAR;
    G_WAIT_V(4); G_BAR;
    G_STAGE(G_SB(1, 0), cB + kstep, clb, 0, RB); G_STAGE(G_SA(1, 0), cA + kstep, cla, 0, RA); G_STAGE(G_SB(1, 1), cB + kstep, clb, 1, RB);
    G_WAIT_V(6); G_BAR;
    for (;;) {
        const bool has_next = S.next(ui + 1, nxt);
        const char* nA = has_next ? nxt.A : cA; const char* nB = has_next ? nxt.B : cB;
        const unsigned nla = has_next ? nxt.lda2 : cla, nlb = has_next ? nxt.ldb2 : clb;
        const int nt = cur.nt;
        for (int t = 0; t < nt; t += 2) {
            const bool last = (t == nt - 2);
            const char* a1 = cA + (size_t)(t + 1) * kstep;
            const char* a2 = last ? nA : cA + (size_t)(t + 2) * kstep; const char* b2 = last ? nB : cB + (size_t)(t + 2) * kstep;
            const unsigned la2 = last ? nla : cla, lb2 = last ? nlb : clb;
            const char* a3 = a2 + kstep; const char* b3 = b2 + kstep;
            G_LDB(B0, 0, 0); G_SCHED; G_LDA(At, 0, 0); G_STAGE(G_SA(1, 1), a1, cla, 1, RA);
            G_WAIT_L(8); G_BAR; G_WAIT_L(0); G_MMA(0, 0, At, B0); G_BAR; G_SCHED;
            G_LDB(B1, 0, 1); G_STAGE(G_SB(0, 0), b2, lb2, 0, RB);
            G_BAR; G_WAIT_L(0); G_MMA(0, 1, At, B1); G_BAR;
            G_LDA(At, 0, 1); G_STAGE(G_SA(0, 0), a2, la2, 0, RA);
            G_BAR; G_WAIT_L(0); G_MMA(1, 0, At, B0); G_BAR; G_SCHED;
            G_STAGE(G_SB(0, 1), b2, lb2, 1, RB);
            G_WAIT_V(6); G_BAR; G_MMA(1, 1, At, B1); G_BAR;
            G_LDB(B0, 1, 0); G_SCHED; G_LDA(At, 1, 0); G_STAGE(G_SA(0, 1), a2, la2, 1, RA);
            G_WAIT_L(8); G_BAR; G_WAIT_L(0); G_MMA(0, 0, At, B0); G_BAR; G_SCHED;
            G_LDB(B1, 1, 1); G_STAGE(G_SB(1, 0), b3, lb2, 0, RB);
            G_BAR; G_WAIT_L(0); G_MMA(0, 1, At, B1); G_BAR;
            G_LDA(At, 1, 1); G_STAGE(G_SA(1, 0), a3, la2, 0, RA);
            G_BAR; G_WAIT_L(0); G_MMA(1, 0, At, B0); G_BAR; G_SCHED;
            G_STAGE(G_SB(1, 1), b3, lb2, 1, RB);
            G_WAIT_V(6); G_BAR; G_MMA(1, 1, At, B1); G_BAR;
        }
        if constexpr (!Epi::AFTER_DRAIN) E(acc, cur, wr, wc, fr, fq);
        if (!has_next) break;
#pragma unroll
        for (int a = 0; a < 2; ++a)
#pragma unroll
            for (int b = 0; b < 2; ++b)
#pragma unroll
                for (int m = 0; m < 4; ++m)
#pragma unroll
                    for (int n = 0; n < 2; ++n) acc[a][b][m][n] = (f32x4){0.f, 0.f, 0.f, 0.f};
        cur = nxt; cA = nA; cB = nB; cla = nla; clb = nlb; ++ui;
    }
    G_WAIT_V(0);
    if (wr == 0) G_BAR;
    G_BAR;
    if constexpr (Epi::AFTER_DRAIN) E.drained(acc, cur, wr, wc, fr, fq, lds);
#undef RA
#undef RB
#undef G_SA
#undef G_SB
#undef G_STAGE
#undef G_LDA
#undef G_LDB
#undef G_MMA
#undef G_WAIT_V
#undef G_WAIT_L
#undef G_BAR
#undef G_SCHED
}

__device__ __forceinline__ bool tile_order(long L, int nM, int nN, int& pm, int& pn) {
    const int nwg = nM * nN; if (L >= nwg) return false;
    int wgid = (int)L; { const int q = nwg / 8, r = nwg % 8, xcd = wgid % 8, off = wgid / 8; wgid = (xcd < r ? xcd * (q + 1) : r * (q + 1) + (xcd - r) * q) + off; }
    const int nig = 8 * nN, gid = wgid / nig, fm = gid * 8, gsz = (nM - fm) < 8 ? (nM - fm) : 8;
    pm = fm + ((wgid % nig) % gsz); pn = (wgid % nig) / gsz; return true;
}

struct SchedG1 { const char* A; const char* B; int G, c;
    __device__ __forceinline__ bool next(int i, Unit& u) const { int pm, pn; if (!tile_order((long)i * G + c, 64, 24, pm, pn)) return false;
        u.A = A + (size_t)pm * 256 * 2048; u.B = B + (size_t)pn * 256 * 2048; u.lda2 = 2048; u.ldb2 = 2048; u.nt = 16; u.tag = 0; u.pm = pm; u.pn = pn; return true; } };
struct EpiG1 { static constexpr bool AFTER_DRAIN = false; char* ws;
    __device__ __forceinline__ void operator()(const f32x4 (&acc)[2][2][4][2], const Unit& u, int wr, int wc, int fr, int fq) const {
        const int seg = u.pn >> 1, cb = (u.pn & 1) * 256 + wc * 32 + 8 * fq;
        bf16_t* base; int ld = 512, coff = 0;
        switch (seg) {
            case 1: base = (bf16_t*)(ws + OFF_S5G); break; case 2: base = (bf16_t*)(ws + OFF_SGUU); break; case 3: base = (bf16_t*)(ws + OFF_SGUV); break;
            case 4: base = (bf16_t*)(ws + OFF_SGUG); break; case 5: base = (bf16_t*)(ws + OFF_M2Z); break;
            case 6: base = (bf16_t*)(ws + OFF_XBC); ld = 1024; break; case 7: base = (bf16_t*)(ws + OFF_XBC); ld = 1024; coff = 512; break;
            case 8: base = (bf16_t*)(ws + OFF_SCB); break; case 9: base = (bf16_t*)(ws + OFF_SCC); break; case 10: base = (bf16_t*)(ws + OFF_SCH); break;
            case 11: base = (bf16_t*)(ws + OFF_SCG); break; default: base = (bf16_t*)(ws + OFF_A2); break;
        }
#pragma unroll
        for (int ai = 0; ai < 2; ++ai)
#pragma unroll
            for (int m = 0; m < 4; ++m) {
                const int row = u.pm * 256 + ai * 128 + wr * 64 + m * 16 + fr;
#pragma unroll
                for (int bj = 0; bj < 2; ++bj) {
                    const int col = cb + bj * 128;
                    const u32x4 v = pack8(acc[ai][bj][m][0], acc[ai][bj][m][1]);
                    bf16_t* dst;
                    if (seg == 0) dst = base + ((size_t)((col >> 4) * 1024 + (row >> 4)) * 384 + 128 + (row & 15) * 16 + (col & 15));
                    else dst = base + (size_t)row * ld + coff + col;
                    *(u32x4*)dst = v;
                }
            }
    } };

struct SchedS1 { char* ws; int G, c;
    __device__ __forceinline__ bool next(int i, Unit& u) const { const long L = (long)i * G + c; if (L >= 128) return false; const int g = (int)L >> 2, pm = (int)L & 3;
        u.A = ws + OFF_A2 + ((size_t)(g * 1024 + pm * 256) * 384 + 128) * 2; u.B = ws + OFF_GTAB + (size_t)g * 128 * 256 * 2; u.lda2 = 768; u.ldb2 = 512; u.nt = 4; u.tag = g; u.pm = pm; u.pn = 0; return true; } };
struct EpiS1 { static constexpr bool AFTER_DRAIN = true;
    __device__ __forceinline__ void drained(const f32x4 (&acc)[2][2][4][2], const Unit& u, int wr, int wc, int fr, int fq, LAS unsigned char* lds) const {
#pragma unroll
        for (int ai = 0; ai < 2; ++ai)
#pragma unroll
            for (int m = 0; m < 4; ++m) { const int row = ai * 128 + wr * 64 + m * 16 + fr;
                *(LAS u32x4*)(lds + (row * 128 + wc * 32 + 8 * fq) * 2) = pack8(acc[ai][0][m][0], acc[ai][0][m][1]); }
    } };
struct SchedS2 { char* ws; int G, c;
    __device__ __forceinline__ bool next(int i, Unit& u) const { const long L = (long)i * G + c; if (L >= 128) return false; const int g = (int)L >> 2, pm = (int)L & 3;
        u.A = ws + OFF_A2 + (size_t)(g * 1024 + pm * 256) * 768; u.B = ws + OFF_B2TAB + (size_t)g * 256 * 768; u.lda2 = 768; u.ldb2 = 768; u.nt = 6; u.tag = g; u.pm = pm; u.pn = 0; return true; } };
struct EpiS2 { static constexpr bool AFTER_DRAIN = false; char* ws; const float* dvec;
    __device__ __forceinline__ void operator()(const f32x4 (&acc)[2][2][4][2], const Unit& u, int, int, int, int) const {
        const int tq = tidx(), wr = tq >> 8, wc = (tq >> 6) & 3, fr = tq & 15, fq = (tq >> 4) & 3;
        const int g = u.tag;
        const bf16_t* a2 = (const bf16_t*)(ws + OFF_A2) + (size_t)g * 1024 * 384;
        bf16_t* ys = (bf16_t*)(ws + OFF_YS5);
#pragma unroll
        for (int bj = 0; bj < 2; ++bj) {
            const int col = bj * 128 + wc * 32 + 8 * fq, t = col >> 4, p0 = col & 15;
            const f32x4 d0 = *(const f32x4*)(dvec + g * 16 + p0), d1 = *(const f32x4*)(dvec + g * 16 + p0 + 4);
            u32x4 uu[2][4];
#pragma unroll
            for (int ai = 0; ai < 2; ++ai)
#pragma unroll
                for (int m = 0; m < 4; ++m) uu[ai][m] = *(const u32x4*)(a2 + (size_t)(u.pm * 256 + ai * 128 + wr * 64 + m * 16 + fr) * 384 + 128 + col);
#pragma unroll
            for (int ai = 0; ai < 2; ++ai)
#pragma unroll
                for (int m = 0; m < 4; ++m) { const int row = u.pm * 256 + ai * 128 + wr * 64 + m * 16 + fr;
                    f32x4 u0, u1; unpack8(uu[ai][m], u0, u1);
                    f32x4 y0 = acc[ai][bj][m][0] + d0 * u0, y1 = acc[ai][bj][m][1] + d1 * u1;
#pragma unroll
                    for (int j = 0; j < 4; ++j) { y0[j] = geluf_(y0[j]); y1[j] = geluf_(y1[j]); }
                    *(u32x4*)(ys + (size_t)(row * 16 + t) * 512 + g * 16 + p0) = pack8(y0, y1); }
            __builtin_amdgcn_sched_barrier(0);
        }
    } };
struct SchedGLU { char* ws; int G, c;
    __device__ __forceinline__ bool next(int i, Unit& u) const { const long L = (long)i * G + c; if (L >= 128) return false; const int pm = (int)L >> 1, pn = (int)L & 1;
        u.A = ws + OFF_YS5 + (size_t)pm * 256 * 1024; u.B = ws + OFF_WGLUT + (size_t)pn * 256 * 1024; u.lda2 = 1024; u.ldb2 = 1024; u.nt = 8; u.tag = 0; u.pm = pm; u.pn = pn; return true; } };
struct EpiGLU { static constexpr bool AFTER_DRAIN = false; char* ws;
    __device__ __forceinline__ void operator()(const f32x4 (&acc)[2][2][4][2], const Unit& u, int, int, int, int) const {
        const int tq = tidx(), wr = tq >> 8, wc = (tq >> 6) & 3, fr = tq & 15, fq = (tq >> 4) & 3;
        const bf16_t* ys = (const bf16_t*)(ws + OFF_YS5); bf16_t* gt = (bf16_t*)(ws + OFF_S5G);
#pragma unroll
        for (int ai = 0; ai < 2; ++ai)
#pragma unroll
            for (int bj = 0; bj < 2; ++bj) {
                u32x4 yy[4], gg[4];
#pragma unroll
                for (int m = 0; m < 4; ++m) { const size_t o = (size_t)(u.pm * 256 + ai * 128 + wr * 64 + m * 16 + fr) * 512 + u.pn * 256 + bj * 128 + wc * 32 + 8 * fq; yy[m] = *(const u32x4*)(ys + o); gg[m] = *(const u32x4*)(gt + o); }
#pragma unroll
                for (int m = 0; m < 4; ++m) { const size_t o = (size_t)(u.pm * 256 + ai * 128 + wr * 64 + m * 16 + fr) * 512 + u.pn * 256 + bj * 128 + wc * 32 + 8 * fq;
                    f32x4 y0, y1, g0, g1; unpack8(yy[m], y0, y1); unpack8(gg[m], g0, g1);
                    f32x4 r0, r1;
#pragma unroll
                    for (int j = 0; j < 4; ++j) { r0[j] = y0[j] * sigmoidf_(acc[ai][bj][m][0][j]) * siluf_(g0[j]); r1[j] = y1[j] * sigmoidf_(acc[ai][bj][m][1][j]) * siluf_(g1[j]); }
                    *(u32x4*)(gt + o) = pack8(r0, r1); }
                __builtin_amdgcn_sched_barrier(0);
            }
    } };
struct SchedP3 { char* ws; int G, c;
    __device__ __forceinline__ bool next(int i, Unit& u) const { int pm, pn; if (!tile_order((long)(i >> 3) * G + c, 64, 4, pm, pn)) return false; const int sub = i & 7, k = sub >> 1;
        if (!(sub & 1)) { u.A = ws + OFF_H + (size_t)pm * 256 * 2048; u.B = ws + OFF_WINT + (size_t)(6144 + k * 1024 + pn * 256) * 2048; u.lda2 = 2048; u.ldb2 = 2048; u.nt = 16; }
        else { const size_t yo = k == 0 ? OFF_S5G : k == 1 ? OFF_SGUU : k == 2 ? OFF_M2Z : OFF_SCB;
            u.A = ws + yo + (size_t)pm * 256 * 1024; u.B = ws + OFF_WBT + (size_t)(k * 1024 + pn * 256) * 1024; u.lda2 = 1024; u.ldb2 = 1024; u.nt = 8; }
        u.tag = sub; u.pm = pm; u.pn = pn; return true; } };
template <int KC> __device__ __forceinline__ void p3_branch_epi(const f32x4 (&acc)[2][2][4][2], char* gsb, char* psb, bf16_t* mg, const Unit& u, int wr, int wc, int fr, int fq) {
#pragma unroll
    for (int ai = 0; ai < 2; ++ai)
#pragma unroll
        for (int bj = 0; bj < 2; ++bj) {
            u32x4 pk[2], pp[4];
#pragma unroll
            for (int mp = 0; mp < 2; ++mp) pk[mp] = *(const u32x4*)(gsb + ((ai * 2 + bj) * 2 + mp) * 8192);
            if (KC > 0) {
#pragma unroll
                for (int m = 0; m < 4; ++m) pp[m] = *(const u32x4*)(psb + ((ai * 2 + bj) * 4 + m) * 8192);
            }
#pragma unroll
            for (int m = 0; m < 4; ++m) { const int slot = (ai * 2 + bj) * 4 + m; const unsigned w0 = pk[m >> 1][(m & 1) * 2], w1 = pk[m >> 1][(m & 1) * 2 + 1];
                f32x4 g0, g1;
#pragma unroll
                for (int j = 0; j < 4; ++j) { g0[j] = (float)((w0 >> (8 * j)) & 0xffu); g1[j] = (float)((w1 >> (8 * j)) & 0xffu); }
                f32x4 v0, v1;
                if (KC > 0) { f32x4 p0, p1; unpack8(pp[m], p0, p1);
#pragma unroll
                    for (int j = 0; j < 4; ++j) { v0[j] = __builtin_fmaf(g0[j], acc[ai][bj][m][0][j], p0[j]); v1[j] = __builtin_fmaf(g1[j], acc[ai][bj][m][1][j], p1[j]); } }
                else { v0 = g0 * acc[ai][bj][m][0]; v1 = g1 * acc[ai][bj][m][1]; }
                if (KC < 3) *(u32x4*)(psb + slot * 8192) = pack8(v0, v1);
                else { const int row = u.pm * 256 + ai * 128 + wr * 64 + m * 16 + fr, col = u.pn * 256 + bj * 128 + wc * 32 + 8 * fq;
                    *(u32x4*)(mg + (size_t)row * 1024 + col) = pack8(v0 * (1.0f / 255.0f), v1 * (1.0f / 255.0f)); }
            }
            __builtin_amdgcn_sched_barrier(0);
        }
}
struct EpiP3 { static constexpr bool AFTER_DRAIN = false; char* ws; const float* mb;
    __device__ __forceinline__ void operator()(const f32x4 (&acc)[2][2][4][2], const Unit& u, int, int, int, int) const {
        const int k = u.tag >> 1;
        const int tq = tidx(), wr = tq >> 8, wc = (tq >> 6) & 3, fr = tq & 15, fq = (tq >> 4) & 3;
        unsigned t16 = (unsigned)tq * 16u; asm volatile("" : "+v"(t16));
        char* gsb = ws + OFF_GS + (size_t)bidx() * (8 * 512 * 16) + t16;
        char* psb = ws + OFF_PART + (size_t)bidx() * (16 * 512 * 16) + t16;
        if (!(u.tag & 1)) {
#pragma unroll
            for (int bj = 0; bj < 2; ++bj) { const int col = u.pn * 256 + bj * 128 + wc * 32 + 8 * fq;
                const f32x4 b0 = *(const f32x4*)(mb + k * 1024 + col) * -1.4426950408889634f, b1 = *(const f32x4*)(mb + k * 1024 + col + 4) * -1.4426950408889634f;
#pragma unroll
                for (int ai = 0; ai < 2; ++ai)
#pragma unroll
                    for (int mp = 0; mp < 2; ++mp) { u32x4 pk;
#pragma unroll
                        for (int mm = 0; mm < 2; ++mm) { const int m = mp * 2 + mm; unsigned w0 = 0u, w1 = 0u;
#pragma unroll
                            for (int j = 0; j < 4; ++j) {
                                const float e0 = __builtin_amdgcn_exp2f(__builtin_fmaf(acc[ai][bj][m][0][j], -1.4426950408889634f, b0[j])), e1 = __builtin_amdgcn_exp2f(__builtin_fmaf(acc[ai][bj][m][1][j], -1.4426950408889634f, b1[j]));
                                w0 = __builtin_amdgcn_cvt_pk_u8_f32(__builtin_amdgcn_rcpf(__builtin_fmaf(e0, 1.0f / 255.0f, 1.0f / 255.0f)), j, w0);
                                w1 = __builtin_amdgcn_cvt_pk_u8_f32(__builtin_amdgcn_rcpf(__builtin_fmaf(e1, 1.0f / 255.0f, 1.0f / 255.0f)), j, w1); }
                            pk[mm * 2] = w0; pk[mm * 2 + 1] = w1; }
                        *(u32x4*)(gsb + ((ai * 2 + bj) * 2 + mp) * 8192) = pk; }
            }
        } else {
            bf16_t* mg = (bf16_t*)(ws + OFF_MERGED);
            if (k == 0) p3_branch_epi<0>(acc, gsb, psb, mg, u, wr, wc, fr, fq);
            else if (k == 3) p3_branch_epi<3>(acc, gsb, psb, mg, u, wr, wc, fr, fq);
            else p3_branch_epi<1>(acc, gsb, psb, mg, u, wr, wc, fr, fq);
        }
    } };
struct SchedP4 { char* ws; int G, c;
    __device__ __forceinline__ bool next(int i, Unit& u) const { int pm, pn; if (!tile_order((long)i * G + c, 64, 4, pm, pn)) return false;
        u.A = ws + OFF_MERGED + (size_t)pm * 256 * 2048; u.B = ws + OFF_WOUTT + (size_t)pn * 256 * 2048; u.lda2 = 2048; u.ldb2 = 2048; u.nt = 16; u.tag = 0; u.pm = pm; u.pn = pn; return true; } };
struct EpiP4 { static constexpr bool AFTER_DRAIN = false; const float* xin; float* xout;
    __device__ __forceinline__ void operator()(const f32x4 (&acc)[2][2][4][2], const Unit& u, int, int, int, int) const {
        const int tq = tidx(), wr = tq >> 8, wc = (tq >> 6) & 3, fr = tq & 15, fq = (tq >> 4) & 3;
#pragma unroll
        for (int ai = 0; ai < 2; ++ai)
#pragma unroll
            for (int bj = 0; bj < 2; ++bj) {
                f32x4 xr[4][2];
#pragma unroll
                for (int m = 0; m < 4; ++m) { const size_t o = (size_t)(u.pm * 256 + ai * 128 + wr * 64 + m * 16 + fr) * 1024 + u.pn * 256 + bj * 128 + wc * 32 + 8 * fq;
                    xr[m][0] = *(const f32x4*)(xin + o); xr[m][1] = *(const f32x4*)(xin + o + 4); }
#pragma unroll
                for (int m = 0; m < 4; ++m) { const size_t o = (size_t)(u.pm * 256 + ai * 128 + wr * 64 + m * 16 + fr) * 1024 + u.pn * 256 + bj * 128 + wc * 32 + 8 * fq;
                    *(f32x4*)(xout + o) = xr[m][0] + acc[ai][bj][m][0]; *(f32x4*)(xout + o + 4) = xr[m][1] + acc[ai][bj][m][1]; }
                __builtin_amdgcn_sched_barrier(0);
            }
    } };

constexpr int LDP = 136;
__device__ __forceinline__ bf16x8 ldfrag(const bf16_t* base, int row, int k0) { return *(const bf16x8*)(base + row * LDP + k0); }
__device__ __forceinline__ int xrow(int p) { return (p & ~7) | ((p + (p >> 3)) & 7); }
__device__ __forceinline__ f32x4 mma16(bf16x8 a, bf16x8 b, f32x4 c) { return __builtin_amdgcn_mfma_f32_16x16x32_bf16(a, b, c, 0, 0, 0); }

__device__ __forceinline__ void transpose_tile(float* tile, const float* src, size_t ldn, bf16_t* dst, size_t ldk) {
    const int tid = tidx();
    {
        const int k0 = tid >> 6, n4 = (tid & 63) * 4;
        f32x4 v[8];
#pragma unroll
        for (int j = 0; j < 8; ++j) v[j] = *(const f32x4*)(src + (size_t)(k0 + j * 8) * ldn + n4);
#pragma unroll
        for (int j = 0; j < 8; ++j) { float* t = tile + (k0 + j * 8) * 257 + n4; t[0] = v[j][0]; t[1] = v[j][1]; t[2] = v[j][2]; t[3] = v[j][3]; }
    }
    __syncthreads();
    {
        const int n = tid >> 1, kb = (tid & 1) * 32;
#pragma unroll
        for (int j = 0; j < 4; ++j) { f32x4 a, b;
#pragma unroll
            for (int e = 0; e < 4; ++e) { a[e] = tile[(kb + j * 8 + e) * 257 + n]; b[e] = tile[(kb + j * 8 + 4 + e) * 257 + n]; }
            *(u32x4*)(dst + (size_t)n * ldk + kb + j * 8) = pack8(a, b); }
    }
    __syncthreads();
}

__device__ void phase_prep_weights(const P& p, int layer, char* smem) {
    float* tile = (float*)smem;
    const float* w_in = p.w_in + (size_t)layer * 1024 * IN_DIM_;
    for (int idx = bidx(); idx < 848; idx += gdim()) {
        if (idx < 640) { const int nt = idx >> 4, kt = idx & 15; const int n0 = nt * 256, so = n0 < 4096 ? n0 : n0 + 8;
            transpose_tile(tile, w_in + (size_t)kt * 64 * IN_DIM_ + so, IN_DIM_, (bf16_t*)(p.ws + OFF_WINT) + (size_t)n0 * 1024 + kt * 64, 1024); }
        else if (idx < 768) { const int j = idx - 640, k = j >> 5, r = j & 31, dt = r >> 3, wt = r & 7;
            transpose_tile(tile, p.w_branch + ((size_t)(layer * 4 + k) * 512 + wt * 64) * 1024 + dt * 256, 1024, (bf16_t*)(p.ws + OFF_WBT) + ((size_t)k * 1024 + dt * 256) * 512 + wt * 64, 512); }
        else if (idx < 832) { const int j = idx - 768, nt = j >> 4, kt = j & 15;
            transpose_tile(tile, p.w_out + ((size_t)layer * 1024 + kt * 64) * 1024 + nt * 256, 1024, (bf16_t*)(p.ws + OFF_WOUTT) + (size_t)nt * 256 * 1024 + kt * 64, 1024); }
        else { const int j = idx - 832, nt = j >> 3, kt = j & 7;
            transpose_tile(tile, p.w_glu + ((size_t)layer * 512 + kt * 64) * 512 + nt * 256, 512, (bf16_t*)(p.ws + OFF_WGLUT) + (size_t)nt * 256 * 512 + kt * 64, 512); }
    }
}

__device__ void phase_s5_tables(const P& p, int layer, char* smem) {
    float* pwr = (float*)smem;
    float* pwi = pwr + 64 * 17;
    float* bbr = pwi + 64 * 17;
    float* bbi = bbr + 1024;
    float* cr = bbi + 1024;
    float* ci = cr + 1024;
    float* kern = ci + 1024;
    const int tid = tidx();
    for (int job = bidx(); job < 256; job += gdim()) {
        const int g = job >> 3, part = job & 7;
        const int lg = layer * 32 + g;
        if (tid < 64) {
            const int n = tid;
            const float step = expf(p.log_step[lg]);
            const float lr = p.lam_re[lg * 64 + n], li = p.lam_im[lg * 64 + n];
            const float mag = expf(lr * step); float sn, cs; sincosf(li * step, &sn, &cs);
            const float abr = mag * cs, abi = mag * sn, den = lr * lr + li * li, nr = abr - 1.0f;
            const float cre = (nr * lr + abi * li) / den, cim = (abi * lr - nr * li) / den;
            double pr = 1.0, pi = 0.0; const double ar = (double)abr, ai = (double)abi;
            for (int j = 0; j <= 16; ++j) { pwr[n * 17 + j] = (float)pr; pwi[n * 17 + j] = (float)pi; const double t0 = pr * ar - pi * ai, t1 = pr * ai + pi * ar; pr = t0; pi = t1; }
            if (part == 0) { float* aq = (float*)(p.ws + OFF_AQ) + (g * 64 + n) * 2; aq[0] = pwr[n * 17 + 16]; aq[1] = pwi[n * 17 + 16]; }
            for (int q = 0; q < 16; ++q) { const float br = p.b_re[((size_t)lg * 64 + n) * 16 + q], bi = p.b_im[((size_t)lg * 64 + n) * 16 + q];
                bbr[n * 16 + q] = cre * br - cim * bi; bbi[n * 16 + q] = cre * bi + cim * br; }
        }
        for (int i = tid; i < 1024; i += 512) { cr[i] = p.c_re[(size_t)lg * 1024 + i]; ci[i] = p.c_im[(size_t)lg * 1024 + i]; }
        __syncthreads();
        const int nlag = 2 * part + 2;
        for (int o = tid; o < nlag * 64; o += 512) { const int j = o >> 6, pp = (o >> 2) & 15, q4 = (o & 3) * 4; f32x4 s4 = (f32x4){0.f, 0.f, 0.f, 0.f};
            for (int n = 0; n < 64; ++n) { const float wr_ = pwr[n * 17 + j], wi_ = pwi[n * 17 + j], c_r = cr[pp * 64 + n], c_i = ci[pp * 64 + n];
                const float dr_ = c_r * wr_ - c_i * wi_, di_ = c_r * wi_ + c_i * wr_;
                const f32x4 br = *(const f32x4*)(bbr + n * 16 + q4), bi = *(const f32x4*)(bbi + n * 16 + q4);
                s4 += dr_ * br - di_ * bi; }
            *(f32x4*)(kern + j * 256 + pp * 16 + q4) = s4; }
        __syncthreads();
        bf16_t* b2 = (bf16_t*)(p.ws + OFF_B2TAB) + (size_t)g * 256 * 384;
        for (int i = tid; i < 32 * 384; i += 512) { const int idx = part * 32 * 384 + i; const int r = idx / 384, k = idx - r * 384, t = r >> 4, pp = r & 15; float v;
            if (k < 64) v = cr[pp * 64 + k] * pwr[k * 17 + t + 1] - ci[pp * 64 + k] * pwi[k * 17 + t + 1];
            else if (k < 128) { const int n = k - 64; v = -(cr[pp * 64 + n] * pwi[n * 17 + t + 1] + ci[pp * 64 + n] * pwr[n * 17 + t + 1]); }
            else { const int s_ = (k - 128) >> 4, q = (k - 128) & 15; v = s_ <= t ? kern[(t - s_) * 256 + pp * 16 + q] : 0.f; }
            b2[idx] = f2bf(v); }
        bf16_t* gt = (bf16_t*)(p.ws + OFF_GTAB) + (size_t)g * 128 * 256;
        for (int i = tid; i < 16 * 256; i += 512) { const int idx = part * 16 * 256 + i; const int np = idx >> 8, kk = idx & 255, s_ = kk >> 4, q = kk & 15, n = np & 63;
            const float wr_ = pwr[n * 17 + 15 - s_], wi_ = pwi[n * 17 + 15 - s_], br = bbr[n * 16 + q], bi = bbi[n * 16 + q];
            gt[idx] = f2bf(np < 64 ? (wr_ * br - wi_ * bi) : (wr_ * bi + wi_ * br)); }
        if (g == 31) { bf16_t* pad = (bf16_t*)(p.ws + OFF_GTAB) + (size_t)32 * 128 * 256 + part * 16 * 256; for (int i = tid; i < 16 * 256; i += 512) pad[i] = 0; }
        __syncthreads();
    }
}

__device__ __forceinline__ float wave_sum(float v) {
#pragma unroll
    for (int o = 32; o > 0; o >>= 1) v += __shfl_xor(v, o, 64);
    return v;
}

__device__ void phase_rmsnorm_h(const P& p, int layer, const float* xin, char* smem) {
    const int tid = tidx(), wid = tid >> 6, lane = tid & 63;
    const float* w_in = p.w_in + (size_t)layer * 1024 * IN_DIM_;
    f32x4 wq[16][2];
#pragma unroll
    for (int j = 0; j < 4; ++j)
#pragma unroll
        for (int e = 0; e < 4; ++e) { const size_t k = (size_t)(j * 256 + lane * 4 + e); wq[j * 4 + e][0] = *(const f32x4*)(w_in + k * IN_DIM_ + 4096); wq[j * 4 + e][1] = *(const f32x4*)(w_in + k * IN_DIM_ + 4100); }
    const float* nw = p.norm_w + layer * 1024;
    bf16_t* h = (bf16_t*)(p.ws + OFF_H); float* dtraw = (float*)(p.ws + OFF_DTRAW);
    f32x4 wv[4];
#pragma unroll
    for (int j = 0; j < 4; ++j) wv[j] = *(const f32x4*)(nw + j * 256 + lane * 4);
    for (int row0 = (bidx() * 8 + wid) * 2; row0 < T_; row0 += gdim() * 16) {
        f32x4 v[2][4]; float ss[2] = {0.f, 0.f};
#pragma unroll
        for (int r = 0; r < 2; ++r)
#pragma unroll
            for (int j = 0; j < 4; ++j) v[r][j] = *(const f32x4*)(xin + (size_t)(row0 + r) * 1024 + j * 256 + lane * 4);
#pragma unroll
        for (int r = 0; r < 2; ++r)
#pragma unroll
            for (int j = 0; j < 4; ++j) ss[r] += v[r][j][0] * v[r][j][0] + v[r][j][1] * v[r][j][1] + v[r][j][2] * v[r][j][2] + v[r][j][3] * v[r][j][3];
        ss[0] = wave_sum(ss[0]); ss[1] = wave_sum(ss[1]);
#pragma unroll
        for (int r = 0; r < 2; ++r) {
            const float rstd = rsqrtf(ss[r] * (1.0f / 1024.0f) + 1e-6f);
            float dacc[8];
#pragma unroll
            for (int e = 0; e < 8; ++e) dacc[e] = 0.f;
#pragma unroll
            for (int j = 0; j < 4; ++j) { const f32x4 hv = v[r][j] * rstd * wv[j];
                u32x2 o; o[0] = cvt_pk_bf16(hv[0], hv[1]); o[1] = cvt_pk_bf16(hv[2], hv[3]);
                *(u32x2*)(h + (size_t)(row0 + r) * 1024 + j * 256 + lane * 4) = o;
#pragma unroll
                for (int e = 0; e < 4; ++e) { const f32x4 w0 = wq[j * 4 + e][0], w1 = wq[j * 4 + e][1];
#pragma unroll
                    for (int q = 0; q < 4; ++q) { dacc[q] += hv[e] * w0[q]; dacc[4 + q] += hv[e] * w1[q]; } }
            }
            const bool h32 = (lane & 32) != 0, h16 = (lane & 16) != 0, h8 = (lane & 8) != 0;
            float a4[4];
#pragma unroll
            for (int e = 0; e < 4; ++e) { const float send = h32 ? dacc[e] : dacc[4 + e]; const float keep = h32 ? dacc[4 + e] : dacc[e]; a4[e] = keep + __shfl_xor(send, 32, 64); }
            float a2[2];
#pragma unroll
            for (int e = 0; e < 2; ++e) { const float send = h16 ? a4[e] : a4[2 + e]; const float keep = h16 ? a4[2 + e] : a4[e]; a2[e] = keep + __shfl_xor(send, 16, 64); }
            float a1; { const float send = h8 ? a2[0] : a2[1]; const float keep = h8 ? a2[1] : a2[0]; a1 = keep + __shfl_xor(send, 8, 64); }
            a1 += __shfl_xor(a1, 4, 64); a1 += __shfl_xor(a1, 2, 64); a1 += __shfl_xor(a1, 1, 64);
            if ((lane & 7) == 0) { const int e = (h32 ? 4 : 0) + (h16 ? 2 : 0) + (h8 ? 1 : 0); dtraw[(size_t)(row0 + r) * 8 + e] = a1; }
        }
    }
    __syncthreads();
}

__device__ void phase_final_norm(const P& p) {
    const int tid = tidx(), wid = tid >> 6, lane = tid & 63;
    f32x4 wv[4];
#pragma unroll
    for (int j = 0; j < 4; ++j) wv[j] = *(const f32x4*)(p.final_w + j * 256 + lane * 4);
    const int rstep = gdim() * 16;
    f32x4 vn[2][4];
    { const int r0_ = (bidx() * 8 + wid) * 2;
#pragma unroll
        for (int r = 0; r < 2; ++r)
#pragma unroll
            for (int j = 0; j < 4; ++j) vn[r][j] = *(const f32x4*)(p.out + (size_t)(r0_ + r) * 1024 + j * 256 + lane * 4); }
    for (int row0 = (bidx() * 8 + wid) * 2; row0 < T_; row0 += rstep) {
        f32x4 v[2][4]; float ss[2] = {0.f, 0.f};
#pragma unroll
        for (int r = 0; r < 2; ++r)
#pragma unroll
            for (int j = 0; j < 4; ++j) v[r][j] = vn[r][j];
        { const int rn = row0 + rstep < T_ ? row0 + rstep : row0;
#pragma unroll
            for (int r = 0; r < 2; ++r)
#pragma unroll
                for (int j = 0; j < 4; ++j) vn[r][j] = *(const f32x4*)(p.out + (size_t)(rn + r) * 1024 + j * 256 + lane * 4); }
#pragma unroll
        for (int r = 0; r < 2; ++r)
#pragma unroll
            for (int j = 0; j < 4; ++j) ss[r] += v[r][j][0] * v[r][j][0] + v[r][j][1] * v[r][j][1] + v[r][j][2] * v[r][j][2] + v[r][j][3] * v[r][j][3];
        ss[0] = wave_sum(ss[0]); ss[1] = wave_sum(ss[1]);
#pragma unroll
        for (int r = 0; r < 2; ++r) { const float rstd = rsqrtf(ss[r] * (1.0f / 1024.0f) + 1e-6f);
#pragma unroll
            for (int j = 0; j < 4; ++j) *(f32x4*)(p.out + (size_t)(row0 + r) * 1024 + j * 256 + lane * 4) = v[r][j] * rstd * wv[j]; }
    }
}

__device__ void phase_sgu(const P& p, int layer, char* smem, int task0, int tstride) {
    bf16_t* vnT = (bf16_t*)smem;
    float* hs = (float*)(smem + 8 * 64 * LDP * 2);
    float* rs = hs + 8 * 128 * 2;
    const int tid = tidx(), w = tid >> 6, lane = tid & 63;
    const bf16_t* vbuf = (const bf16_t*)(p.ws + OFF_SGUV); const bf16_t* gbuf = (const bf16_t*)(p.ws + OFF_SGUG); bf16_t* ubuf = (bf16_t*)(p.ws + OFF_SGUU);
    const float* lnw = p.ln_w + layer * 512 + w * 64; const float* lnb = p.ln_b + layer * 512 + w * 64;
    const float* Wm = p.sgu_w + ((size_t)layer * 8 + w) * 128 * 128; const float* bs = p.sgu_b + (layer * 8 + w) * 128;
    for (int task = task0; task < 128; task += tstride) {
        const size_t tok0 = (size_t)task * 128;
        const int r8 = lane >> 3, e0 = (lane & 7) * 8;
        bf16_t* my = vnT + (size_t)w * 64 * LDP;
#pragma unroll 1
        for (int hb = 0; hb < 2; ++hb) {
        u32x4 vraw[8];
#pragma unroll
        for (int it = 0; it < 8; ++it) vraw[it] = *(const u32x4*)(vbuf + (tok0 + (hb * 8 + it) * 8 + r8) * 512 + w * 64 + e0);
#pragma unroll
        for (int it = 0; it < 8; ++it) { const int s = (hb * 8 + it) * 8 + r8;
            f32x4 a, b; unpack8(vraw[it], a, b);
            float sm = 0.f, sq = 0.f;
#pragma unroll
            for (int j = 0; j < 4; ++j) { const float x0 = geluf_(a[j]), x1 = geluf_(b[j]); sm += x0 + x1; sq += x0 * x0 + x1 * x1;
                my[xrow(e0 + j) * LDP + s] = f2bf(x0); my[xrow(e0 + 4 + j) * LDP + s] = f2bf(x1); }
#pragma unroll
            for (int o = 1; o < 8; o <<= 1) { sm += __shfl_xor(sm, o, 64); sq += __shfl_xor(sq, o, 64); }
            if ((lane & 7) == 0) { hs[(w * 128 + s) * 2] = sm; hs[(w * 128 + s) * 2 + 1] = sq; }
        }
        }
        __syncthreads();
        if (tid < 128) { float sm = 0.f, sq = 0.f;
#pragma unroll
            for (int hh = 0; hh < 8; ++hh) { sm += hs[(hh * 128 + tid) * 2]; sq += hs[(hh * 128 + tid) * 2 + 1]; }
            const float mu = sm * (1.0f / 512.0f); const float var = fmaxf(sq * (1.0f / 512.0f) - mu * mu, 0.f);
            rs[tid * 2] = mu; rs[tid * 2 + 1] = rsqrtf(var + 1e-6f); }
        __syncthreads();
        {
            const f32x4 lw0 = *(const f32x4*)(lnw + e0), lw1 = *(const f32x4*)(lnw + e0 + 4), lb0 = *(const f32x4*)(lnb + e0), lb1 = *(const f32x4*)(lnb + e0 + 4);
#pragma unroll 4
            for (int it = 0; it < 16; ++it) { const int s = it * 8 + r8;
                const float mu = rs[s * 2], rstd = rs[s * 2 + 1];
#pragma unroll
                for (int j = 0; j < 4; ++j) { bf16_t* q0 = my + xrow(e0 + j) * LDP + s; bf16_t* q1 = my + xrow(e0 + 4 + j) * LDP + s;
                    *q0 = f2bf((bf2f(*q0) - mu) * rstd * lw0[j] + lb0[j]); *q1 = f2bf((bf2f(*q1) - mu) * rstd * lw1[j] + lb1[j]); }
            }
        }
        __syncthreads();
        {
            const int fr = lane & 15, kq = lane >> 4;
            f32x4 wq[4][2]; u32x2 uq[4], gq[4]; float btq;
#define SGU_LOAD(NT) do { const int t_ = (NT) * 16 + fr; \
                _Pragma("unroll") for (int ks = 0; ks < 4; ++ks) { wq[ks][0] = *(const f32x4*)(Wm + (size_t)t_ * 128 + ks * 32 + kq * 8); wq[ks][1] = *(const f32x4*)(Wm + (size_t)t_ * 128 + ks * 32 + kq * 8 + 4); } \
                _Pragma("unroll") for (int mt = 0; mt < 4; ++mt) { const size_t o_ = (tok0 + t_) * 512 + w * 64 + mt * 16 + kq * 4; uq[mt] = *(const u32x2*)(ubuf + o_); gq[mt] = *(const u32x2*)(gbuf + o_); } \
                btq = bs[t_]; } while (0)
            SGU_LOAD(0);
#pragma unroll 1
            for (int nt = 0; nt < 8; ++nt) {
                f32x4 acc[4];
#pragma unroll
                for (int mt = 0; mt < 4; ++mt) acc[mt] = (f32x4){0.f, 0.f, 0.f, 0.f};
                const int t = nt * 16 + fr;
                bf16x8 bfr[4];
#pragma unroll
                for (int ks = 0; ks < 4; ++ks) { const int s0 = ks * 32 + kq * 8; f32x4 m0, m1;
#pragma unroll
                    for (int j = 0; j < 4; ++j) { m0[j] = (s0 + j <= t) ? wq[ks][0][j] : 0.f; m1[j] = (s0 + 4 + j <= t) ? wq[ks][1][j] : 0.f; }
                    const u32x4 bw = pack8(m0, m1); bfr[ks] = *(const bf16x8*)&bw; }
                u32x2 uc[4], gc[4]; const float bt = btq;
#pragma unroll
                for (int mt = 0; mt < 4; ++mt) { uc[mt] = uq[mt]; gc[mt] = gq[mt]; }
                if (nt < 7) SGU_LOAD(nt + 1);
#pragma unroll
                for (int ks = 0; ks < 4; ++ks) if (ks <= (nt >> 1)) {
                    const int s0 = ks * 32 + kq * 8;
#pragma unroll
                    for (int mt = 0; mt < 4; ++mt) acc[mt] = mma16(ldfrag(my, xrow(mt * 16 + fr), s0), bfr[ks], acc[mt]);
                }
                const size_t tok = tok0 + t;
#pragma unroll
                for (int mt = 0; mt < 4; ++mt) { const size_t o = tok * 512 + w * 64 + mt * 16 + kq * 4;
                    const u32x2 uu = uc[mt], gg = gc[mt];
                    const float u0 = bflo(uu[0]), u1 = bfhi(uu[0]), u2 = bflo(uu[1]), u3 = bfhi(uu[1]);
                    const float g0 = bflo(gg[0]), g1 = bfhi(gg[0]), g2 = bflo(gg[1]), g3 = bfhi(gg[1]);
                    u32x2 r; r[0] = cvt_pk_bf16(geluf_(u0) * (acc[mt][0] + bt) * siluf_(g0), geluf_(u1) * (acc[mt][1] + bt) * siluf_(g1));
                    r[1] = cvt_pk_bf16(geluf_(u2) * (acc[mt][2] + bt) * siluf_(g2), geluf_(u3) * (acc[mt][3] + bt) * siluf_(g3));
                    *(u32x2*)(ubuf + o) = r; }
            }
#undef SGU_LOAD
        }
        __syncthreads();
    }
}

__device__ void phase_m2_local(const P& p, int layer, char* smem) {
    bf16_t* Cs = (bf16_t*)smem;
    bf16_t* Bs = Cs + 128 * LDP;
    bf16_t* BTs = Bs + 128 * LDP;
    bf16_t* xT = BTs + 128 * LDP;
    float* dts4 = (float*)(xT + 64 * LDP);
    float* acs4 = dts4 + 512;
    float* das4 = acs4 + 512;
    const int tid = tidx(), w = tid >> 6, lane = tid & 63, fr = lane & 15, kq = lane >> 4;
    const bf16_t* xbc = (const bf16_t*)(p.ws + OFF_XBC); const float* dtraw = (const float*)(p.ws + OFF_DTRAW);
    const float* cw = p.conv_w + (size_t)layer * 4 * 1024; const float* cbv = p.conv_b + layer * 1024;
    for (int task = bidx(); task < 256; task += gdim()) {
        const int grp = task & 1, c = (task >> 1) & 15, b = task >> 5;
        const size_t tok0 = (size_t)b * SEQ_ + c * 128;
        {
            const int h4 = tid >> 7, l = tid & 127, hd = grp * 4 + h4;
            const float aneg = -__expf(p.a_log[layer * 8 + hd]);
            const float dr = dtraw[(tok0 + l) * 8 + hd] + p.dt_bias[layer * 8 + hd]; const float e_ = __expf(dr), u_ = 1.0f + e_; const float dt = dr > 20.f ? dr : (u_ == 1.0f ? e_ : __logf(u_) * e_ * __builtin_amdgcn_rcpf(u_ - 1.0f));
            dts4[tid] = dt; das4[tid] = dt * aneg;
            float s_ = dt * aneg;
#pragma unroll
            for (int o = 1; o < 64; o <<= 1) { const float t = __shfl_up(s_, o, 64); if ((tid & 63) >= o) s_ += t; }
            __syncthreads();
            if (l >= 64) { float tot = 0.f; const float* dh = das4 + h4 * 128;
                for (int j = 0; j < 64; j += 4) tot += dh[j] + dh[j + 1] + dh[j + 2] + dh[j + 3];
                s_ += tot; }
            acs4[tid] = s_;
            ((float*)(p.ws + OFF_EACS))[(tok0 + l) * 8 + hd] = __expf(s_);
            if (l == 127) ((float*)(p.ws + OFF_ACH))[(b * 16 + c) * 8 + hd] = s_;
        }
        {
            const int cgi = tid & 31, run = tid >> 5, l0 = run * 8;
            const int ch = cgi < 16 ? 512 + grp * 128 + cgi * 8 : 768 + grp * 128 + (cgi - 16) * 8, n0 = (cgi & 15) * 8;
            f32x4 wk[4][2], bias0 = *(const f32x4*)(cbv + ch), bias1 = *(const f32x4*)(cbv + ch + 4);
#pragma unroll
            for (int k = 0; k < 4; ++k) { wk[k][0] = *(const f32x4*)(cw + k * 1024 + ch); wk[k][1] = *(const f32x4*)(cw + k * 1024 + ch + 4); }
            f32x4 h0[3], h1[3];
#pragma unroll
            for (int j = 0; j < 3; ++j) { const int l = l0 - 3 + j; const bool ok = c * 128 + l >= 0;
                u32x4 rw = *(const u32x4*)(xbc + (tok0 + (ok ? l : 0)) * 1024 + ch); if (!ok) rw = (u32x4){0u, 0u, 0u, 0u};
                unpack8(rw, h0[j], h1[j]); }
#pragma unroll 1
            for (int hb = 0; hb < 2; ++hb) {
            u32x4 raw[4];
#pragma unroll
            for (int i = 0; i < 4; ++i) raw[i] = *(const u32x4*)(xbc + (tok0 + l0 + hb * 4 + i) * 1024 + ch);
#pragma unroll
            for (int i = 0; i < 4; ++i) { const int l = l0 + hb * 4 + i;
                f32x4 c0, c1; unpack8(raw[i], c0, c1);
                f32x4 o0 = bias0 + wk[0][0] * h0[0] + wk[1][0] * h0[1] + wk[2][0] * h0[2] + wk[3][0] * c0;
                f32x4 o1 = bias1 + wk[0][1] * h1[0] + wk[1][1] * h1[1] + wk[2][1] * h1[2] + wk[3][1] * c1;
                h0[0] = h0[1]; h0[1] = h0[2]; h0[2] = c0; h1[0] = h1[1]; h1[1] = h1[2]; h1[2] = c1;
#pragma unroll
                for (int j = 0; j < 4; ++j) { o0[j] = siluf_(o0[j]); o1[j] = siluf_(o1[j]); }
                const u32x4 pk = pack8(o0, o1);
                if (cgi < 16) *(u32x4*)(Bs + l * LDP + n0) = pk;
                else { *(u32x4*)(Cs + l * LDP + n0) = pk; *(u32x4*)((bf16_t*)(p.ws + OFF_CCONV) + (tok0 + l) * 256 + grp * 128 + n0) = pk; }
            }
            }
        }
        __syncthreads();
        const int ntile = (w | 1) + 1;
        u32x2 g16[8];
        {
            f32x4 g[8];
#pragma unroll
            for (int st = 0; st < 8; ++st) g[st] = (f32x4){0.f, 0.f, 0.f, 0.f};
#pragma unroll
            for (int ks = 0; ks < 4; ++ks) { const bf16x8 a = ldfrag(Cs, w * 16 + fr, ks * 32 + kq * 8);
#pragma unroll
                for (int st = 0; st < 8; ++st) if (st < ntile) g[st] = mma16(a, ldfrag(Bs, st * 16 + fr, ks * 32 + kq * 8), g[st]); }
#pragma unroll
            for (int st = 0; st < 8; ++st) { g16[st][0] = cvt_pk_bf16(g[st][0], g[st][1]); g16[st][1] = cvt_pk_bf16(g[st][2], g[st][3]); }
        }
#pragma unroll 1
        for (int h4 = 0; h4 < 4; ++h4) {
            const int hd = grp * 4 + h4;
            const float* dts = dts4 + h4 * 128; const float* acs = acs4 + h4 * 128;
            __syncthreads();
            const float alast = acs[127];
            {
                const int cgx = tid & 7, run = tid >> 3, l0 = run * 2, ch = hd * 64 + cgx * 8, p0 = cgx * 8;
                f32x4 wk[4][2], bias0 = *(const f32x4*)(cbv + ch), bias1 = *(const f32x4*)(cbv + ch + 4);
#pragma unroll
                for (int k = 0; k < 4; ++k) { wk[k][0] = *(const f32x4*)(cw + k * 1024 + ch); wk[k][1] = *(const f32x4*)(cw + k * 1024 + ch + 4); }
                f32x4 r0[5], r1[5];
#pragma unroll
                for (int j = 0; j < 5; ++j) { const int l = l0 - 3 + j; const bool ok = c * 128 + l >= 0;
                    u32x4 rw = *(const u32x4*)(xbc + (tok0 + (ok ? l : 0)) * 1024 + ch); if (!ok) rw = (u32x4){0u, 0u, 0u, 0u};
                    unpack8(rw, r0[j], r1[j]); }
#pragma unroll
                for (int i = 0; i < 2; ++i) { const int l = l0 + i;
                    f32x4 o0 = bias0 + wk[0][0] * r0[i] + wk[1][0] * r0[i + 1] + wk[2][0] * r0[i + 2] + wk[3][0] * r0[i + 3];
                    f32x4 o1 = bias1 + wk[0][1] * r1[i] + wk[1][1] * r1[i + 1] + wk[2][1] * r1[i + 2] + wk[3][1] * r1[i + 3];
#pragma unroll
                    for (int j = 0; j < 4; ++j) { xT[(p0 + j) * LDP + l] = f2bf(siluf_(o0[j])); xT[(p0 + 4 + j) * LDP + l] = f2bf(siluf_(o1[j])); } }
            }
#pragma unroll
            for (int i = 0; i < 4; ++i) { const int pr = tid + i * 512, l = pr & 127, n0 = (pr >> 7) * 8;
                f32x4 b0, b1; unpack8(*(const u32x4*)(Bs + l * LDP + n0), b0, b1);
                const float sc = dts[l] * __expf(alast - acs[l]);
#pragma unroll
                for (int j = 0; j < 4; ++j) { BTs[(n0 + j) * LDP + l] = f2bf(b0[j] * sc); BTs[(n0 + 4 + j) * LDP + l] = f2bf(b1[j] * sc); } }
#pragma unroll
            for (int st = 0; st < 8; ++st) if (st < ntile) { const int s_ = st * 16 + fr; const float as_ = acs[s_], ds_ = dts[s_];
#pragma unroll
                for (int r = 0; r < 4; ++r) { const int l = w * 16 + kq * 4 + r; const float gv = (r & 1) ? bfhi(g16[st][r >> 1]) : bflo(g16[st][r >> 1]); const float v = (s_ <= l) ? gv * __expf(acs[l] - as_) * ds_ : 0.f; Cs[l * LDP + s_] = f2bf(v); } }
            __syncthreads();
            {
                f32x4 y[4];
#pragma unroll
                for (int mt = 0; mt < 4; ++mt) y[mt] = (f32x4){0.f, 0.f, 0.f, 0.f};
                for (int ks = 0; ks <= (w >> 1); ++ks) { const bf16x8 bfrag = ldfrag(Cs, w * 16 + fr, ks * 32 + kq * 8);
#pragma unroll
                    for (int mt = 0; mt < 4; ++mt) y[mt] = mma16(ldfrag(xT, mt * 16 + fr, ks * 32 + kq * 8), bfrag, y[mt]); }
                const int l = w * 16 + fr; const float dd = p.m2_d[layer * 8 + hd];
                bf16_t* yp = (bf16_t*)(p.ws + OFF_YPART) + (tok0 + l) * 512 + hd * 64;
#pragma unroll
                for (int mt = 0; mt < 4; ++mt) { const int p0 = mt * 16 + kq * 4; f32x4 v;
#pragma unroll
                    for (int r = 0; r < 4; ++r) v[r] = y[mt][r] + dd * bf2f(xT[(p0 + r) * LDP + l]);
                    u32x2 o; o[0] = cvt_pk_bf16(v[0], v[1]); o[1] = cvt_pk_bf16(v[2], v[3]); *(u32x2*)(yp + p0) = o; }
            }
            {
                f32x4 st_[4];
#pragma unroll
                for (int pt = 0; pt < 4; ++pt) st_[pt] = (f32x4){0.f, 0.f, 0.f, 0.f};
#pragma unroll
                for (int ks = 0; ks < 4; ++ks) { const bf16x8 a = ldfrag(BTs, w * 16 + fr, ks * 32 + kq * 8);
#pragma unroll
                    for (int pt = 0; pt < 4; ++pt) st_[pt] = mma16(a, ldfrag(xT, pt * 16 + fr, ks * 32 + kq * 8), st_[pt]); }
                bf16_t* sb = (bf16_t*)(p.ws + OFF_M2ST) + (size_t)((b * 16 + c) * 8 + hd) * 64 * 128;
#pragma unroll
                for (int pt = 0; pt < 4; ++pt) { const int pp = pt * 16 + fr, n0 = w * 16 + kq * 4;
                    u32x2 o; o[0] = cvt_pk_bf16(st_[pt][0], st_[pt][1]); o[1] = cvt_pk_bf16(st_[pt][2], st_[pt][3]); *(u32x2*)(sb + pp * 128 + n0) = o; }
            }
        }
        __syncthreads();
    }
}

__device__ __forceinline__ void phase_m2_carry(const P& p, int vb, int nvb) {
    const int tid = tidx();
    for (int idx = vb * 512 + tid; idx < 8 * 8 * 64 * 32; idx += nvb * 512) {
        const int n4 = idx & 31, pp = (idx >> 5) & 63, hd = (idx >> 11) & 7, b = idx >> 14;
        bf16_t* base = (bf16_t*)(p.ws + OFF_M2ST) + (size_t)(b * 16 * 8 + hd) * 8192 + pp * 128 + n4 * 4;
        const float* ach = (const float*)(p.ws + OFF_ACH) + b * 16 * 8 + hd;
        u32x2 ld[16];
#pragma unroll
        for (int c = 0; c < 16; ++c) ld[c] = *(const u32x2*)(base + (size_t)c * 8 * 8192);
        float decq[16];
#pragma unroll
        for (int c = 0; c < 16; ++c) decq[c] = ach[c * 8];
        f32x4 S = (f32x4){0.f, 0.f, 0.f, 0.f};
#pragma unroll
        for (int c = 0; c < 16; ++c) { u32x2 o; o[0] = cvt_pk_bf16(S[0], S[1]); o[1] = cvt_pk_bf16(S[2], S[3]); *(u32x2*)(base + (size_t)c * 8 * 8192) = o;
            const float dec = __expf(decq[c]);
            S[0] = dec * S[0] + bflo(ld[c][0]); S[1] = dec * S[1] + bfhi(ld[c][0]); S[2] = dec * S[2] + bflo(ld[c][1]); S[3] = dec * S[3] + bfhi(ld[c][1]); }
    }
}
__device__ void s5_carry_unit(const P& p, char* smem, int g, int pm) {
    const int tid = tidx();
    float* ex = (float*)(smem + 65536);
    const bf16_t* sloc = (const bf16_t*)smem;
    __syncthreads();
    for (int bb = 0; bb < 2; ++bb) {
        const int b = pm * 2 + bb, n = tid & 63, seg = tid >> 6;
        const float aqr = ((const float*)(p.ws + OFF_AQ))[(g * 64 + n) * 2], aqi = ((const float*)(p.ws + OFF_AQ))[(g * 64 + n) * 2 + 1];
        const bf16_t* sl = sloc + (bb * 128 + seg * 16) * 128;
        bf16_t* a2 = (bf16_t*)(p.ws + OFF_A2) + ((size_t)g * 1024 + b * 128 + seg * 16) * 384;
        float lr[16], li[16];
#pragma unroll
        for (int j = 0; j < 16; ++j) { lr[j] = bf2f(sl[j * 128 + n]); li[j] = bf2f(sl[j * 128 + 64 + n]); }
        float sr = 0.f, si = 0.f;
#pragma unroll
        for (int j = 0; j < 16; ++j) { const float t0 = aqr * sr - aqi * si + lr[j], t1 = aqr * si + aqi * sr + li[j]; sr = t0; si = t1; }
        __syncthreads();
        ex[(seg * 64 + n) * 2] = sr; ex[(seg * 64 + n) * 2 + 1] = si;
        __syncthreads();
        float pr = aqr, pi = aqi;
#pragma unroll
        for (int j = 0; j < 4; ++j) { const float t0 = pr * pr - pi * pi, t1 = 2.f * pr * pi; pr = t0; pi = t1; }
        float cr_ = 0.f, ci_ = 0.f;
        for (int s_ = 0; s_ < seg; ++s_) { const float er = ex[(s_ * 64 + n) * 2], ei = ex[(s_ * 64 + n) * 2 + 1]; const float t0 = pr * cr_ - pi * ci_ + er, t1 = pr * ci_ + pi * cr_ + ei; cr_ = t0; ci_ = t1; }
        sr = cr_; si = ci_;
#pragma unroll
        for (int j = 0; j < 16; ++j) { a2[j * 384 + n] = f2bf(sr); a2[j * 384 + 64 + n] = f2bf(si);
            const float t0 = aqr * sr - aqi * si + lr[j], t1 = aqr * si + aqi * sr + li[j]; sr = t0; si = t1; }
    }
    asm volatile("s_waitcnt vmcnt(0)" ::: "memory");
    __syncthreads();
}

__device__ void phase_m2_out(const P& p, int layer, char* smem) {
    float* ssq = (float*)smem;
    float* rst = ssq + 512;
    const int tid = tidx(), w = tid >> 6, lane = tid & 63, fr = lane & 15, kq = lane >> 4, grp = w >> 2;
    const bf16_t* cc = (const bf16_t*)(p.ws + OFF_CCONV); const bf16_t* yp = (const bf16_t*)(p.ws + OFF_YPART); bf16_t* zb = (bf16_t*)(p.ws + OFF_M2Z);
    const float* eacs = (const float*)(p.ws + OFF_EACS); const float* nw = p.m2_norm_w + layer * 512 + w * 64;
    for (int task = bidx(); task < 256; task += gdim()) {
        const int half = task & 1, c = (task >> 1) & 15, b = task >> 5;
        const size_t tok0 = (size_t)b * SEQ_ + c * 128 + half * 64;
        const bf16_t* sin_ = (const bf16_t*)(p.ws + OFF_M2ST) + (size_t)((b * 16 + c) * 8 + w) * 8192;
        f32x4 acc[4][4];
#pragma unroll
        for (int mt = 0; mt < 4; ++mt)
#pragma unroll
            for (int nt = 0; nt < 4; ++nt) acc[mt][nt] = (f32x4){0.f, 0.f, 0.f, 0.f};
#pragma unroll
        for (int ks = 0; ks < 4; ++ks) { bf16x8 a[4];
#pragma unroll
            for (int mt = 0; mt < 4; ++mt) a[mt] = *(const bf16x8*)(sin_ + (mt * 16 + fr) * 128 + ks * 32 + kq * 8);
#pragma unroll
            for (int nt = 0; nt < 4; ++nt) { const bf16x8 bb = *(const bf16x8*)(cc + (tok0 + nt * 16 + fr) * 256 + grp * 128 + ks * 32 + kq * 8);
#pragma unroll
                for (int mt = 0; mt < 4; ++mt) acc[mt][nt] = mma16(a[mt], bb, acc[mt][nt]); } }
        u32x2 yq[4][4], zq[4][4]; float eaq[4];
#pragma unroll
        for (int nt = 0; nt < 4; ++nt) { const size_t tok = tok0 + nt * 16 + fr; eaq[nt] = eacs[tok * 8 + w];
#pragma unroll
            for (int mt = 0; mt < 4; ++mt) { const size_t o = tok * 512 + w * 64 + mt * 16 + kq * 4; yq[nt][mt] = *(const u32x2*)(yp + o); zq[nt][mt] = *(const u32x2*)(zb + o); } }
#pragma unroll
        for (int nt = 0; nt < 4; ++nt) { const float ea = eaq[nt]; float ss = 0.f;
#pragma unroll
            for (int mt = 0; mt < 4; ++mt) {
                const u32x2 yy = yq[nt][mt], zz = zq[nt][mt];
                f32x4 v; v[0] = (bflo(yy[0]) + ea * acc[mt][nt][0]) * siluf_(bflo(zz[0])); v[1] = (bfhi(yy[0]) + ea * acc[mt][nt][1]) * siluf_(bfhi(zz[0]));
                v[2] = (bflo(yy[1]) + ea * acc[mt][nt][2]) * siluf_(bflo(zz[1])); v[3] = (bfhi(yy[1]) + ea * acc[mt][nt][3]) * siluf_(bfhi(zz[1]));
                acc[mt][nt] = v; ss += v[0] * v[0] + v[1] * v[1] + v[2] * v[2] + v[3] * v[3]; }
            ss += __shfl_xor(ss, 16, 64); ss += __shfl_xor(ss, 32, 64);
            if (kq == 0) ssq[w * 64 + nt * 16 + fr] = ss; }
        __syncthreads();
        if (tid < 64) { float s = 0.f;
#pragma unroll
            for (int hh = 0; hh < 8; ++hh) s += ssq[hh * 64 + tid];
            rst[tid] = rsqrtf(s * (1.0f / 512.0f) + 1e-6f); }
        __syncthreads();
        f32x4 wvn[4];
#pragma unroll
        for (int mt = 0; mt < 4; ++mt) wvn[mt] = *(const f32x4*)(nw + mt * 16 + kq * 4);
#pragma unroll
        for (int nt = 0; nt < 4; ++nt) { const size_t tok = tok0 + nt * 16 + fr; const float r = rst[nt * 16 + fr];
#pragma unroll
            for (int mt = 0; mt < 4; ++mt) { const int p0 = mt * 16 + kq * 4; const f32x4 v = acc[mt][nt] * r * wvn[mt];
                u32x2 o; o[0] = cvt_pk_bf16(v[0], v[1]); o[1] = cvt_pk_bf16(v[2], v[3]); *(u32x2*)(zb + tok * 512 + w * 64 + p0) = o; } }
        __syncthreads();
    }
}

__device__ __forceinline__ void phase_shortconv(const P& p, int layer, int vb, int nvb) {
    const bf16_t* cb = (const bf16_t*)(p.ws + OFF_SCC); const bf16_t* hb = (const bf16_t*)(p.ws + OFF_SCH); const bf16_t* gb = (const bf16_t*)(p.ws + OFF_SCG); bf16_t* bb = (bf16_t*)(p.ws + OFF_SCB);
    const float* cw = p.sc_w + (size_t)layer * 3 * 512;
    for (int idx = vb * 512 + tidx(); idx < (T_ / 8) * 64; idx += nvb * 512) {
        const int cgp = idx & 63, run = idx >> 6, ch = cgp * 8; const size_t t0 = (size_t)run * 8; const int lseq = (int)(t0 & (SEQ_ - 1));
        f32x4 w0[3], w1[3];
#pragma unroll
        for (int k = 0; k < 3; ++k) { w0[k] = *(const f32x4*)(cw + k * 512 + ch); w1[k] = *(const f32x4*)(cw + k * 512 + ch + 4); }
        f32x4 pa0[2], pa1[2];
#pragma unroll
        for (int j = 0; j < 2; ++j) { const bool ok = lseq - 2 + j >= 0; const size_t o = (ok ? t0 - 2 + j : t0) * 512 + ch;
            u32x4 wc_ = *(const u32x4*)(cb + o), wh_ = *(const u32x4*)(hb + o); if (!ok) { wc_ = (u32x4){0u, 0u, 0u, 0u}; wh_ = wc_; }
            f32x4 c0, c1, h0, h1; unpack8(wc_, c0, c1); unpack8(wh_, h0, h1); pa0[j] = c0 * h0; pa1[j] = c1 * h1; }
#pragma unroll
        for (int hbt = 0; hbt < 2; ++hbt) {
            u32x4 rc[4], rh[4], rb[4], rg[4];
#pragma unroll
            for (int i = 0; i < 4; ++i) { const size_t o = (t0 + hbt * 4 + i) * 512 + ch; rc[i] = *(const u32x4*)(cb + o); rh[i] = *(const u32x4*)(hb + o); rb[i] = *(const u32x4*)(bb + o); rg[i] = *(const u32x4*)(gb + o); }
#pragma unroll
            for (int i = 0; i < 4; ++i) { const size_t o = (t0 + hbt * 4 + i) * 512 + ch;
                f32x4 c0, c1, h0, h1, b0, b1, g0, g1; unpack8(rc[i], c0, c1); unpack8(rh[i], h0, h1); unpack8(rb[i], b0, b1); unpack8(rg[i], g0, g1);
                const f32x4 q0 = c0 * h0, q1 = c1 * h1;
                f32x4 y0 = b0 * (w0[0] * pa0[0] + w0[1] * pa0[1] + w0[2] * q0), y1 = b1 * (w1[0] * pa1[0] + w1[1] * pa1[1] + w1[2] * q1);
#pragma unroll
                for (int j = 0; j < 4; ++j) { y0[j] *= siluf_(g0[j]); y1[j] *= siluf_(g1[j]); }
                *(u32x4*)(bb + o) = pack8(y0, y1);
                pa0[0] = pa0[1]; pa0[1] = q0; pa1[0] = pa1[1]; pa1[1] = q1; }
        }
    }
}

#define XB_TMO      128
#define XB_XCNT(j)  (256  + 64 * (j))
#define XB_XSUB(j)  (1280 + 64 * (j))
#define XB_XGEN(j)  (2304 + 64 * (j))
#define XB_TOP      3328
#define XB_TOPGEN   3392
#define XCD_BAR_WORDS 3456
#define XB_SPIN_CAP (1u << 20)
__device__ __forceinline__ unsigned xb_ld(unsigned* p)              { return __hip_atomic_load(p, __ATOMIC_RELAXED, __HIP_MEMORY_SCOPE_AGENT); }
__device__ __forceinline__ unsigned xb_add(unsigned* p, unsigned v) { return __hip_atomic_fetch_add(p, v, __ATOMIC_RELAXED, __HIP_MEMORY_SCOPE_AGENT); }
__device__ __forceinline__ unsigned xb_xcc_id() { return (unsigned)__builtin_amdgcn_s_getreg((3 << 11) | 20) & 0xFu; }
#define XB_SPIN(cond, bar) do { unsigned _sp = 0; while (cond) { __builtin_amdgcn_s_sleep(1); \
    if ((++_sp & 255u) == 0u) { if (xb_ld(&(bar)[XB_TMO])) break; if (_sp > XB_SPIN_CAP) { atomicAdd(&(bar)[XB_TMO], 1u); break; } } } } while (0)
struct XcdBarrier { unsigned* bar; unsigned x; volatile LAS unsigned* st; };
__device__ __forceinline__ XcdBarrier xcd_barrier_post(unsigned* bar, volatile LAS unsigned* st) {
    XcdBarrier b; b.bar = bar; b.x = xb_xcc_id(); b.st = st;
    if (__builtin_amdgcn_workitem_id_x() == 0) (void)xb_add(&bar[XB_XCNT(b.x)], 1u);
    return b;
}
__device__ __forceinline__ void xcd_barrier_complete(unsigned* bar, unsigned x, unsigned& nloc, unsigned& nx) {
    const unsigned G = (unsigned)gdim();
    unsigned sum, cnt, mine, sp = 0u;
    for (;;) {
        sum = 0u; cnt = 0u; mine = 0u;
        unsigned cv[16];
#pragma unroll
        for (unsigned j = 0; j < 16; ++j) cv[j] = xb_ld(&bar[XB_XCNT(j)]);
#pragma unroll
        for (unsigned j = 0; j < 16; ++j) { const unsigned c = cv[j]; sum += c; cnt += (c > 0u) ? 1u : 0u; mine = (j == x) ? c : mine; }
        if (sum == G) break;
        __builtin_amdgcn_s_sleep(1);
        if ((++sp & 255u) == 0u) { if (xb_ld(&bar[XB_TMO])) break; if (sp > XB_SPIN_CAP) { atomicAdd(&bar[XB_TMO], 1u); break; } }
    }
    nloc = mine > 0u ? mine : 1u; nx = cnt > 0u ? cnt : 1u;
}
__device__ __forceinline__ void xcd_barrier(const XcdBarrier& b) {
    asm volatile("s_waitcnt vmcnt(0)" ::: "memory");
    __syncthreads();
    if (__builtin_amdgcn_workitem_id_x() == 0) {
        unsigned* bar = b.bar;
        __builtin_amdgcn_s_waitcnt(0);
        unsigned nloc = b.st[0], nx = b.st[1];
        if (nloc == 0u) { xcd_barrier_complete(bar, b.x, nloc, nx); b.st[0] = nloc; b.st[1] = nx; }
        const unsigned old = xb_add(&bar[XB_XSUB(b.x)], 1u);
        const unsigned gen = old / nloc;
        if (old + 1u == (gen + 1u) * nloc) {
            __builtin_amdgcn_fence(__ATOMIC_RELEASE, "agent");
            asm volatile("s_waitcnt vmcnt(0)" ::: "memory");
            const unsigned og = xb_add(&bar[XB_TOP], 1u);
            const unsigned tg = og / nx;
            if (og + 1u == (tg + 1u) * nx) xb_add(&bar[XB_TOPGEN], 1u);
            else XB_SPIN(xb_ld(&bar[XB_TOPGEN]) == tg, bar);
            __builtin_amdgcn_fence(__ATOMIC_ACQUIRE, "agent");
            xb_add(&bar[XB_XGEN(b.x)], 1u);
            asm volatile("s_waitcnt vmcnt(0)" ::: "memory");
        } else {
            XB_SPIN(xb_ld(&bar[XB_XGEN(b.x)]) == gen, bar);
            __builtin_amdgcn_fence(__ATOMIC_ACQUIRE, "agent");
            asm volatile("s_waitcnt vmcnt(0)" ::: "memory");
        }
    }
    __syncthreads();
}


template <int PH> __device__ __forceinline__ void run_phase(const P& p, int layer, char* smem) {
    LAS unsigned char* lds = (LAS unsigned char*)smem;
    const int G = gdim(), c = bidx();
    const float* xin = layer == 0 ? p.x : p.out;
    if (PH == 0) { phase_prep_weights(p, layer, smem); phase_s5_tables(p, layer, smem); phase_rmsnorm_h(p, layer, xin, smem); }
    if (PH == 1) { SchedG1 S{p.ws + OFF_H, p.ws + OFF_WINT, G, c}; EpiG1 E{p.ws}; gemm_phase(lds, S, E); }
    if (PH == 2) {
        for (int L = c; L < 128; L += G) {
            { SchedS1 S{p.ws, 128, L}; EpiS1 E{}; gemm_phase(lds, S, E); }
            s5_carry_unit(p, smem, L >> 2, L & 3);
            { SchedS2 S{p.ws, 128, L}; EpiS2 E{p.ws, p.s5_d + layer * 512}; gemm_phase(lds, S, E); }
        }
        const bool split = G > 128; const int vb = split ? c - 128 : c, nvb = split ? G - 128 : G;
        phase_sgu(p, layer, smem, split ? (vb >= 0 ? vb : 128) : c, nvb);
        phase_m2_local(p, layer, smem);
        { const int vs = split ? (c < 128 ? c : -1) : c, nvs = split ? 128 : G; if (vs >= 0) phase_shortconv(p, layer, vs, nvs); } }
    if (PH == 3) {
        { SchedGLU S{p.ws, G, c}; EpiGLU E{p.ws}; gemm_phase(lds, S, E); }
        { const bool split = G > 128; const int vb = split ? c - 128 : c, nvb = split ? G - 128 : G; if (vb >= 0) phase_m2_carry(p, vb, nvb); } }
    if (PH == 4) { phase_m2_out(p, layer, smem); }
    if (PH == 6) { SchedP3 S{p.ws, G, c}; EpiP3 E{p.ws, p.merge_b + layer * 4096}; gemm_phase(lds, S, E); }
    if (PH == 7) { SchedP4 S{p.ws, G, c}; EpiP4 E{xin, p.out}; gemm_phase(lds, S, E); }
    if (PH == 8) { phase_final_norm(p); }
}

template <int PH> __global__ void __launch_bounds__(512, 2) k_phase(P p, int layer) {
    extern __shared__ __attribute__((aligned(16))) char smem[];
    run_phase<PH>(p, layer, smem);
}

#if MEGA
__global__ void __launch_bounds__(512, 2) k_mega(P p) {
    extern __shared__ __attribute__((aligned(16))) char smem[];
    cg::grid_group grid = cg::this_grid();
    if (p.ws == nullptr) grid.sync();
    volatile LAS unsigned* xbw = (volatile LAS unsigned*)(LAS unsigned char*)(smem + SMEM_BYTES - 16);
    if (__builtin_amdgcn_workitem_id_x() == 0) { xbw[0] = 0u; xbw[1] = 0u;
        const unsigned xcc = xb_xcc_id(), rank = xb_add((unsigned*)(p.ws + OFF_BAR) + 4 * xcc, 1u);
        xbw[2] = (unsigned)__builtin_amdgcn_workgroup_id_x();
        xbw[3] = rank * 8u + xcc; }
    __syncthreads();
    const XcdBarrier xb = xcd_barrier_post((unsigned*)(p.ws + OFF_BAR), xbw);
    for (int step = 0; step < 15; ++step) {
        P q = p;
        asm volatile("" : "+s"(q.ws), "+s"(q.out), "+s"(q.x));
        int layer = __builtin_amdgcn_readfirstlane(step / 7); const int ph = step - 7 * layer;
        asm volatile("" : "+s"(layer));
        if (step == 14) { run_phase<8>(q, 0, smem); break; }
        switch (ph) {
            case 0: run_phase<0>(q, layer, smem); break;
            case 1: run_phase<1>(q, layer, smem); break;
            case 2: run_phase<2>(q, layer, smem); break;
            case 3: run_phase<3>(q, layer, smem); break;
            case 4: run_phase<4>(q, layer, smem); break;
            case 5: run_phase<6>(q, layer, smem); break;
            default: run_phase<7>(q, layer, smem); break;
        }
        xcd_barrier(xb);
        if (step == 0) {
            if (__builtin_amdgcn_workitem_id_x() == 0) { bool ok = gdim() == 256;
                unsigned cv[16];
#pragma unroll
                for (unsigned j = 0; j < 16; ++j) cv[j] = xb_ld((unsigned*)(p.ws + OFF_BAR) + XB_XCNT(j));
#pragma unroll
                for (unsigned j = 0; j < 16; ++j) ok = ok && (cv[j] == (j < 8u ? 32u : 0u));
                if (ok) xbw[2] = xbw[3]; }
            __syncthreads();
        }
    }
}
#endif

template <int PH> static void launch_phase(const P& p, int layer, hipStream_t stream) {
    static bool attr = false;
    if (!attr) { hipFuncSetAttribute((const void*)k_phase<PH>, hipFuncAttributeMaxDynamicSharedMemorySize, SMEM_BYTES); attr = true; }
    hipLaunchKernelGGL(k_phase<PH>, dim3(256), dim3(512), SMEM_BYTES, stream, p, layer);
}

extern "C" void kernel_launch(void* const* d_in, const int* in_sizes, int n_in, void* d_out, int out_size, void* d_ws, size_t ws_size, hipStream_t stream) {
    if (ws_size < WS_NEED) { fprintf(stderr, "workspace too small: %zu < %zu\n", ws_size, (size_t)WS_NEED); return; }
    P p{};
    const float** f = (const float**)&p;
    for (int i = 0; i < 27; ++i) f[i] = (const float*)d_in[i];
    p.out = (float*)d_out; p.ws = (char*)d_ws;
#if MEGA
    static int grid_blocks = 0;
    if (!grid_blocks) {
        hipFuncSetAttribute((const void*)k_mega, hipFuncAttributeMaxDynamicSharedMemorySize, SMEM_BYTES);
        int dev = 0, cus = 0, per_cu = 0; hipGetDevice(&dev); hipDeviceGetAttribute(&cus, hipDeviceAttributeMultiprocessorCount, dev);
        hipOccupancyMaxActiveBlocksPerMultiprocessor(&per_cu, k_mega, 512, SMEM_BYTES);
        if (per_cu > 1) per_cu = 1;
        grid_blocks = cus * per_cu;
    }
    (void)hipMemsetAsync((char*)d_ws + OFF_BAR, 0, XCD_BAR_WORDS * 4, stream);
    void* args[] = {&p};
    hipError_t e = hipLaunchCooperativeKernel((const void*)k_mega, dim3(grid_blocks), dim3(512), args, SMEM_BYTES, stream);
    if (e != hipSuccess) fprintf(stderr, "cooperative launch failed: %s (grid %d)\n", hipGetErrorString(e), grid_blocks);
#else
    for (int layer = 0; layer < 2; ++layer) {
#define LP(ph) do { launch_phase<ph>(p, layer, stream); if (PROBE_PH == ph) { launch_phase<ph>(p, layer, stream); launch_phase<ph>(p, layer, stream); } } while (0)
        LP(0); LP(1); LP(2); LP(3); LP(4); LP(6); LP(7);
    }
    launch_phase<8>(p, 0, stream);
#endif
}
```

```cpp
#include <hip/hip_runtime.h>
#include <hip/hip_cooperative_groups.h>
#include <cstdio>
namespace cg = cooperative_groups;

#ifndef MEGA
#define MEGA 1
#endif
#ifndef PROBE_PH
#define PROBE_PH -1
#endif
#ifndef PROBE_SUB
#define PROBE_SUB 0
#endif

#define LAS __attribute__((address_space(3)))
typedef unsigned short bf16_t;
typedef short bf16x8 __attribute__((ext_vector_type(8)));
typedef float f32x4 __attribute__((ext_vector_type(4)));
typedef float f32x2 __attribute__((ext_vector_type(2)));
typedef unsigned u32x4 __attribute__((ext_vector_type(4)));
typedef unsigned u32x2 __attribute__((ext_vector_type(2)));

constexpr int SMEM_BYTES = 150528;
#define VBID_LDS_OFF (SMEM_BYTES - 8)
constexpr int T_ = 16384, D_ = 1024, W_ = 512, SEQ_ = 2048;
constexpr int IN_DIM_ = 10248;
constexpr size_t MiB = 1048576;
constexpr size_t OFF_WINT = 0, OFF_WBT = 20 * MiB, OFF_WOUTT = 24 * MiB, OFF_WGLUT = 26 * MiB, OFF_DTRAW = 26 * MiB + MiB / 2,
                 OFF_H = 27 * MiB, OFF_A2 = 59 * MiB, OFF_S5G = 83 * MiB, OFF_SGUU = 99 * MiB, OFF_M2Z = 115 * MiB, OFF_SCB = 131 * MiB,
                 OFF_SGUV = 147 * MiB, OFF_SGUG = 163 * MiB, OFF_XBC = 179 * MiB, OFF_SCC = 211 * MiB, OFF_SCH = 227 * MiB, OFF_SCG = 243 * MiB,
                 OFF_B2TAB = 259 * MiB, OFF_GTAB = 265 * MiB, OFF_YS5 = 267 * MiB + MiB / 4, OFF_M2ST = 283 * MiB + MiB / 4,
                 OFF_YPART = 299 * MiB + MiB / 4, OFF_EACS = 315 * MiB + MiB / 4, OFF_ACH = 315 * MiB + 3 * MiB / 4, OFF_AQ = 315 * MiB + 7 * MiB / 8,
                 OFF_BAR = 316 * MiB, WS_NEED = 316 * MiB + 16384;
constexpr size_t OFF_CCONV = 0;
constexpr size_t OFF_MERGED = OFF_XBC, OFF_GS = OFF_SCC, OFF_PART = OFF_SCG;

struct P {
    const float *x, *norm_w, *w_in, *lam_re, *lam_im, *b_re, *b_im, *c_re, *c_im, *s5_d, *log_step, *w_glu, *ln_w, *ln_b, *sgu_w, *sgu_b,
        *conv_w, *conv_b, *dt_bias, *a_log, *m2_d, *m2_norm_w, *sc_w, *merge_b, *w_branch, *w_out, *final_w;
    float* out;
    char* ws;
};

typedef __bf16 bf16v2 __attribute__((ext_vector_type(2)));
__device__ __forceinline__ unsigned cvt_pk_bf16(float lo, float hi) { const f32x2 v = {lo, hi}; const bf16v2 b = __builtin_convertvector(v, bf16v2); return __builtin_bit_cast(unsigned, b); }
__device__ __forceinline__ int tidx() { int t = __builtin_amdgcn_workitem_id_x(); asm volatile("" : "+v"(t)); return t; }
#if MEGA
__device__ __forceinline__ int bidx() { int t = (int)*(volatile LAS unsigned*)(VBID_LDS_OFF); t = __builtin_amdgcn_readfirstlane(t); asm volatile("" : "+s"(t)); return t; }
#else
__device__ __forceinline__ int bidx() { int t = __builtin_amdgcn_workgroup_id_x(); asm volatile("" : "+s"(t)); return t; }
#endif
__device__ __forceinline__ int gdim() { int t = (int)__builtin_amdgcn_grid_size_x() / (int)__builtin_amdgcn_workgroup_size_x(); asm volatile("" : "+s"(t)); return t; }
__device__ __forceinline__ bf16_t f2bf(float f) { return (bf16_t)(cvt_pk_bf16(f, 0.f) & 0xffffu); }
__device__ __forceinline__ float bf2f(unsigned b) { return __uint_as_float(b << 16); }
__device__ __forceinline__ float bflo(unsigned w) { return __uint_as_float(w << 16); }
__device__ __forceinline__ float bfhi(unsigned w) { return __uint_as_float(w & 0xffff0000u); }
__device__ __forceinline__ float sigmoidf_(float z) { return __builtin_amdgcn_rcpf(1.0f + __expf(-z)); }
__device__ __forceinline__ float siluf_(float z) { return z * sigmoidf_(z); }
__device__ __forceinline__ float sig2f_(float a, float b) { return __builtin_amdgcn_rcpf((1.0f + __expf(-a)) * (1.0f + __expf(-b))); }
__device__ __forceinline__ float geluarg_(float v) { return 1.5957691216f * (v + 0.044715f * v * v * v); }
__device__ __forceinline__ float geluf_(float v) { const float z = 1.5957691216f * (v + 0.044715f * v * v * v); return v * sigmoidf_(z); }
__device__ __forceinline__ u32x4 pack8(const f32x4 a, const f32x4 b) { u32x4 r; r[0] = cvt_pk_bf16(a[0], a[1]); r[1] = cvt_pk_bf16(a[2], a[3]); r[2] = cvt_pk_bf16(b[0], b[1]); r[3] = cvt_pk_bf16(b[2], b[3]); return r; }
__device__ __forceinline__ void unpack8(const u32x4 r, f32x4& a, f32x4& b) { a[0] = bflo(r[0]); a[1] = bfhi(r[0]); a[2] = bflo(r[1]); a[3] = bfhi(r[1]); b[0] = bflo(r[2]); b[1] = bfhi(r[2]); b[2] = bflo(r[3]); b[3] = bfhi(r[3]); }

constexpr int BM = 256, BK = 64, HALF = 128, HTB = HALF * BK * 2, STAGE_BYTES = 8 * HTB;
__device__ __forceinline__ int lds_byte(int r, int c) { const int st = (r >> 4) * 2 + (c >> 5), rr = r & 15, cc = c & 31, ob = rr * 64 + cc * 2; return st * 1024 + (ob ^ (((ob >> 9) & 1) << 5)); }
__device__ __forceinline__ void stage_rc(int b, int& R, int& C) { const int st = b / 1024, sb = b % 1024, swz = sb ^ (((sb >> 9) & 1) << 5); R = (st >> 1) * 16 + swz / 64; C = (st & 1) * 32 + (swz % 64) / 2; }
__device__ __forceinline__ int perm32(int rho) { const int n = rho >> 4, i = rho & 15; return 8 * (i >> 2) + 4 * n + (i & 3); }

struct Unit { const char* A; const char* B; unsigned lda2, ldb2; int nt, tag, pm, pn; };

template <class Epi, class Sched>
__device__ __forceinline__ void gemm_phase(LAS unsigned char* lds, const Sched& S, const Epi& E) {
    const int tid = tidx(), wid = __builtin_amdgcn_readfirstlane(tid >> 6), lane = tid & 63, wr = wid >> 2, wc = wid & 3, fr = lane & 15, fq = lane >> 4;
    unsigned pkR = 0u, pkC = 0u;
#pragma unroll
    for (int i = 0; i < 2; ++i) { int R, C; stage_rc(tid * 16 + i * 8192, R, C); pkR |= ((unsigned)R << (8 * i)) | ((unsigned)((R & ~31) + perm32(R & 31)) << (16 + 8 * i)); pkC |= ((unsigned)C * 2u) << (8 * i); }
#define RA 0
#define RB 16
    const size_t kstep = (size_t)(BK * 2);
    const unsigned ldsw = (unsigned)wid * 1024u;
    const int aoff = lds_byte(wr * 64 + fr, fq * 8), boff = lds_byte(wc * 32 + fr, fq * 8);
#define G_SA(b, h) (((b) * 2 + (h)) * HTB)
#define G_SB(b, h) ((4 + (b) * 2 + (h)) * HTB)
#define G_STAGE(bufoff, gbase, ld2, hf, RV) do { _Pragma("unroll") for (int _i = 0; _i < 2; ++_i) \
        __builtin_amdgcn_global_load_lds((const unsigned*)((const char*)(gbase) + (size_t)(((unsigned)(hf) * HALF + ((pkR >> (RV + 8 * _i)) & 0xffu)) * (ld2) + ((pkC >> (8 * _i)) & 0xffu))), (LAS unsigned*)(lds + (bufoff) + ldsw + _i * 8192), 16, 0, 0); } while (0)
#define G_LDA(dst, b, h) do { _Pragma("unroll") for (int m = 0; m < 4; ++m) _Pragma("unroll") for (int k = 0; k < 2; ++k) dst[m][k] = *(const LAS bf16x8*)(lds + G_SA(b, h) + aoff + m * 2048 + k * 1024); } while (0)
#define G_LDB(dst, b, h) do { _Pragma("unroll") for (int n = 0; n < 2; ++n) _Pragma("unroll") for (int k = 0; k < 2; ++k) dst[n][k] = *(const LAS bf16x8*)(lds + G_SB(b, h) + boff + n * 2048 + k * 1024); } while (0)
#define G_MMA(ai, bj, At, Bt) do { __builtin_amdgcn_s_setprio(1); _Pragma("unroll") for (int m = 0; m < 4; ++m) _Pragma("unroll") for (int n = 0; n < 2; ++n) _Pragma("unroll") for (int k = 0; k < 2; ++k) \
        acc[ai][bj][m][n] = __builtin_amdgcn_mfma_f32_16x16x32_bf16(Bt[n][k], At[m][k], acc[ai][bj][m][n], 0, 0, 0); __builtin_amdgcn_s_setprio(0); } while (0)
#define G_WAIT_V(n) asm volatile("s_waitcnt vmcnt(" #n ")" ::: "memory")
#define G_WAIT_L(n) asm volatile("s_waitcnt lgkmcnt(" #n ")" ::: "memory")
#define G_BAR __builtin_amdgcn_s_barrier()
#define G_SCHED __builtin_amdgcn_sched_barrier(0)
    Unit cur, nxt; int ui = 0;
    if (!S.next(0, cur)) return;
    f32x4 acc[2][2][4][2];
#pragma unroll
    for (int a = 0; a < 2; ++a)
#pragma unroll
        for (int b = 0; b < 2; ++b)
#pragma unroll
            for (int m = 0; m < 4; ++m)
#pragma unroll
                for (int n = 0; n < 2; ++n) acc[a][b][m][n] = (f32x4){0.f, 0.f, 0.f, 0.f};
    bf16x8 At[4][2], B0[2][2], B1[2][2];
    const char* cA = cur.A; const char* cB = cur.B; unsigned cla = cur.lda2, clb = cur.ldb2;
    G_STAGE(G_SB(0, 0), cB, clb, 0, RB); G_STAGE(G_SA(0, 0), cA, cla, 0, RA); G_STAGE(G_SB(0, 1), cB, clb, 1, RB); G_STAGE(G_SA(0, 1), cA, cla, 1, RA);
    if (wr == 1) G_BAR;
    G_WAIT_V(4); G_BAR;
    G_STAGE(G_SB(1, 0), cB + kstep, clb, 0, RB); G_STAGE(G_SA(1, 0), cA + kstep, cla, 0, RA); G_STAGE(G_SB(1, 1), cB + kstep, clb, 1, RB);
    G_WAIT_V(6); G_BAR;
    for (;;) {
        const bool has_next = S.next(ui + 1, nxt);
        const char* nA = has_next ? nxt.A : cA; const char* nB = has_next ? nxt.B : cB;
        const unsigned nla = has_next ? nxt.lda2 : cla, nlb = has_next ? nxt.ldb2 : clb;
        const int nt = cur.nt;
        for (int t = 0; t < nt; t += 2) {
            const bool last = (t == nt - 2);
            const char* a1 = cA + (size_t)(t + 1) * kstep;
            const char* a2 = last ? nA : cA + (size_t)(t + 2) * kstep; const char* b2 = last ? nB : cB + (size_t)(t + 2) * kstep;
            const unsigned la2 = last ? nla : cla, lb2 = last ? nlb : clb;
            const char* a3 = a2 + kstep; const char* b3 = b2 + kstep;
            G_LDB(B0, 0, 0); G_SCHED; G_LDA(At, 0, 0); G_STAGE(G_SA(1, 1), a1, cla, 1, RA);
            G_WAIT_L(8); G_BAR; G_WAIT_L(0); G_MMA(0, 0, At, B0); G_BAR; G_SCHED;
            G_LDB(B1, 0, 1); G_STAGE(G_SB(0, 0), b2, lb2, 0, RB);
            G_BAR; G_WAIT_L(0); G_MMA(0, 1, At, B1); G_BAR;
            G_LDA(At, 0, 1); G_STAGE(G_SA(0, 0), a2, la2, 0, RA);
            G_BAR; G_WAIT_L(0); G_MMA(1, 0, At, B0); G_BAR; G_SCHED;
            G_STAGE(G_SB(0, 1), b2, lb2, 1, RB);
            G_WAIT_V(6); G_BAR; G_MMA(1, 1, At, B1); G_BAR;
            G_LDB(B0, 1, 0); G_SCHED; G_LDA(At, 1, 0); G_STAGE(G_SA(0, 1), a2, la2, 1, RA);
            G_WAIT_L(8); G_BAR; G_WAIT_L(0); G_MMA(0, 0, At, B0); G_BAR; G_SCHED;
            G_LDB(B1, 1, 1); G_STAGE(G_SB(1, 0), b3, lb2, 0, RB);
            G_BAR; G_WAIT_L(0); G_MMA(0, 1, At, B1); G_BAR;
            G_LDA(At, 1, 1); G_STAGE(G_SA(1, 0), a3, la2, 0, RA);
            G_BAR; G_WAIT_L(0); G_MMA(1, 0, At, B0); G_BAR; G_SCHED;
            G_STAGE(G_SB(1, 1), b3, lb2, 1, RB);
            G_WAIT_V(6); G_BAR; G_MMA(1, 1, At, B1); G_BAR;
        }
        if constexpr (!Epi::AFTER_DRAIN) E(acc, cur, wr, wc, fr, fq);
        if (!has_next) break;
#pragma unroll
        for (int a = 0; a < 2; ++a)
#pragma unroll
            for (int b = 0; b < 2; ++b)
#pragma unroll
                for (int m = 0; m < 4; ++m)
#pragma unroll
                    for (int n = 0; n < 2; ++n) acc[a][b][m][n] = (f32x4){0.f, 0.f, 0.f, 0.f};
        cur = nxt; cA = nA; cB = nB; cla = nla; clb = nlb; ++ui;
    }
    G_WAIT_V(0);
    if (wr == 0) G_BAR;
    G_BAR;
    if constexpr (Epi::AFTER_DRAIN) E.drained(acc, cur, wr, wc, fr, fq, lds);
#undef RA
#undef RB
#undef G_SA
#undef G_SB
#undef G_STAGE
#undef G_LDA
#undef G_LDB
#undef G_MMA
#undef G_WAIT_V
#undef G_WAIT_L
#undef G_BAR
#undef G_SCHED
}

__device__ __forceinline__ bool tile_order(long L, int nM, int nN, int& pm, int& pn) {
    const int nwg = nM * nN; if (L >= nwg) return false;
    int wgid = (int)L; { const int q = nwg / 8, r = nwg % 8, xcd = wgid % 8, off = wgid / 8; wgid = (xcd < r ? xcd * (q + 1) : r * (q + 1) + (xcd - r) * q) + off; }
    const int nig = 8 * nN, gid = wgid / nig, fm = gid * 8, gsz = (nM - fm) < 8 ? (nM - fm) : 8;
    pm = fm + ((wgid % nig) % gsz); pn = (wgid % nig) / gsz; return true;
}

struct SchedG1 { const char* A; const char* B; int G, c;
    __device__ __forceinline__ bool next(int i, Unit& u) const { int pm, pn; if (!tile_order((long)i * G + c, 64, 24, pm, pn)) return false;
        u.A = A + (size_t)pm * 256 * 2048; u.B = B + (size_t)pn * 256 * 2048; u.lda2 = 2048; u.ldb2 = 2048; u.nt = 16; u.tag = 0; u.pm = pm; u.pn = pn; return true; } };
struct EpiG1 { static constexpr bool AFTER_DRAIN = false; char* ws;
    __device__ __forceinline__ void operator()(const f32x4 (&acc)[2][2][4][2], const Unit& u, int wr, int wc, int fr, int fq) const {
        const int seg = u.pn >> 1, cb = (u.pn & 1) * 256 + wc * 32 + 8 * fq;
        bf16_t* base; int ld = 512, coff = 0;
        switch (seg) {
            case 1: base = (bf16_t*)(ws + OFF_S5G); break; case 2: base = (bf16_t*)(ws + OFF_SGUU); break; case 3: base = (bf16_t*)(ws + OFF_SGUV); break;
            case 4: base = (bf16_t*)(ws + OFF_SGUG); break; case 5: base = (bf16_t*)(ws + OFF_M2Z); break;
            case 6: base = (bf16_t*)(ws + OFF_XBC); ld = 1024; break; case 7: base = (bf16_t*)(ws + OFF_XBC); ld = 1024; coff = 512; break;
            case 8: base = (bf16_t*)(ws + OFF_SCB); break; case 9: base = (bf16_t*)(ws + OFF_SCC); break; case 10: base = (bf16_t*)(ws + OFF_SCH); break;
            case 11: base = (bf16_t*)(ws + OFF_SCG); break; default: base = (bf16_t*)(ws + OFF_A2); break;
        }
#pragma unroll
        for (int ai = 0; ai < 2; ++ai)
#pragma unroll
            for (int m = 0; m < 4; ++m) {
                const int row = u.pm * 256 + ai * 128 + wr * 64 + m * 16 + fr;
#pragma unroll
                for (int bj = 0; bj < 2; ++bj) {
                    const int col = cb + bj * 128;
                    const u32x4 v = pack8(acc[ai][bj][m][0], acc[ai][bj][m][1]);
                    bf16_t* dst;
                    if (seg == 0) dst = base + ((size_t)((col >> 4) * 1024 + (row >> 4)) * 384 + 128 + (row & 15) * 16 + (col & 15));
                    else dst = base + (size_t)row * ld + coff + col;
                    *(u32x4*)dst = v;
                }
            }
    } };

struct SchedS1 { char* ws; int G, c;
    __device__ __forceinline__ bool next(int i, Unit& u) const { const long L = (long)i * G + c; if (L >= 128) return false; const int g = (int)L >> 2, pm = (int)L & 3;
        u.A = ws + OFF_A2 + ((size_t)(g * 1024 + pm * 256) * 384 + 128) * 2; u.B = ws + OFF_GTAB + (size_t)g * 128 * 256 * 2; u.lda2 = 768; u.ldb2 = 512; u.nt = 4; u.tag = g; u.pm = pm; u.pn = 0; return true; } };
struct EpiS1 { static constexpr bool AFTER_DRAIN = true;
    __device__ __forceinline__ void drained(const f32x4 (&acc)[2][2][4][2], const Unit& u, int wr, int wc, int fr, int fq, LAS unsigned char* lds) const {
#pragma unroll
        for (int ai = 0; ai < 2; ++ai)
#pragma unroll
            for (int m = 0; m < 4; ++m) { const int row = ai * 128 + wr * 64 + m * 16 + fr;
                *(LAS u32x4*)(lds + (row * 128 + wc * 32 + 8 * fq) * 2) = pack8(acc[ai][0][m][0], acc[ai][0][m][1]); }
    } };
struct SchedS2 { char* ws; int G, c;
    __device__ __forceinline__ bool next(int i, Unit& u) const { const long L = (long)i * G + c; if (L >= 128) return false; const int g = (int)L >> 2, pm = (int)L & 3;
        u.A = ws + OFF_A2 + (size_t)(g * 1024 + pm * 256) * 768; u.B = ws + OFF_B2TAB + (size_t)g * 256 * 768; u.lda2 = 768; u.ldb2 = 768; u.nt = 6; u.tag = g; u.pm = pm; u.pn = 0; return true; } };
struct EpiS2 { static constexpr bool AFTER_DRAIN = false; char* ws; const float* dvec;
    __device__ __forceinline__ void operator()(const f32x4 (&acc)[2][2][4][2], const Unit& u, int, int, int, int) const {
        const int tq = tidx(), wr = tq >> 8, wc = (tq >> 6) & 3, fr = tq & 15, fq = (tq >> 4) & 3;
        const int g = u.tag;
        const bf16_t* a2 = (const bf16_t*)(ws + OFF_A2) + (size_t)g * 1024 * 384;
        bf16_t* ys = (bf16_t*)(ws + OFF_YS5);
#pragma unroll
        for (int bj = 0; bj < 2; ++bj) {
            const int col = bj * 128 + wc * 32 + 8 * fq, t = col >> 4, p0 = col & 15;
            const f32x4 d0 = *(const f32x4*)(dvec + g * 16 + p0), d1 = *(const f32x4*)(dvec + g * 16 + p0 + 4);
            u32x4 uu[2][4];
#pragma unroll
            for (int ai = 0; ai < 2; ++ai)
#pragma unroll
                for (int m = 0; m < 4; ++m) uu[ai][m] = *(const u32x4*)(a2 + (size_t)(u.pm * 256 + ai * 128 + wr * 64 + m * 16 + fr) * 384 + 128 + col);
#pragma unroll
            for (int ai = 0; ai < 2; ++ai)
#pragma unroll
                for (int m = 0; m < 4; ++m) { const int row = u.pm * 256 + ai * 128 + wr * 64 + m * 16 + fr;
                    f32x4 u0, u1; unpack8(uu[ai][m], u0, u1);
                    f32x4 y0 = acc[ai][bj][m][0] + d0 * u0, y1 = acc[ai][bj][m][1] + d1 * u1;
#pragma unroll
                    for (int j = 0; j < 4; ++j) { y0[j] = geluf_(y0[j]); y1[j] = geluf_(y1[j]); }
                    *(u32x4*)(ys + (size_t)(row * 16 + t) * 512 + g * 16 + p0) = pack8(y0, y1); }
            __builtin_amdgcn_sched_barrier(0);
        }
    } };
struct SchedGLU { char* ws; int G, c;
    __device__ __forceinline__ bool next(int i, Unit& u) const { const long L = (long)i * G + c; if (L >= 128) return false; const int pm = (int)L >> 1, pn = (int)L & 1;
        u.A = ws + OFF_YS5 + (size_t)pm * 256 * 1024; u.B = ws + OFF_WGLUT + (size_t)pn * 256 * 1024; u.lda2 = 1024; u.ldb2 = 1024; u.nt = 8; u.tag = 0; u.pm = pm; u.pn = pn; return true; } };
struct EpiGLU { static constexpr bool AFTER_DRAIN = false; char* ws;
    __device__ __forceinline__ void operator()(const f32x4 (&acc)[2][2][4][2], const Unit& u, int, int, int, int) const {
        const int tq = tidx(), wr = tq >> 8, wc = (tq >> 6) & 3, fr = tq & 15, fq = (tq >> 4) & 3;
        const bf16_t* ys = (const bf16_t*)(ws + OFF_YS5); bf16_t* gt = (bf16_t*)(ws + OFF_S5G);
#pragma unroll
        for (int ai = 0; ai < 2; ++ai)
#pragma unroll
            for (int bj = 0; bj < 2; ++bj) {
                u32x4 yy[4], gg[4];
#pragma unroll
                for (int m = 0; m < 4; ++m) { const size_t o = (size_t)(u.pm * 256 + ai * 128 + wr * 64 + m * 16 + fr) * 512 + u.pn * 256 + bj * 128 + wc * 32 + 8 * fq; yy[m] = *(const u32x4*)(ys + o); gg[m] = *(const u32x4*)(gt + o); }
#pragma unroll
                for (int m = 0; m < 4; ++m) { const size_t o = (size_t)(u.pm * 256 + ai * 128 + wr * 64 + m * 16 + fr) * 512 + u.pn * 256 + bj * 128 + wc * 32 + 8 * fq;
                    f32x4 y0, y1, g0, g1; unpack8(yy[m], y0, y1); unpack8(gg[m], g0, g1);
                    f32x4 r0, r1;
#pragma unroll
                    for (int j = 0; j < 4; ++j) { r0[j] = y0[j] * g0[j] * sig2f_(acc[ai][bj][m][0][j], g0[j]); r1[j] = y1[j] * g1[j] * sig2f_(acc[ai][bj][m][1][j], g1[j]); }
                    *(u32x4*)(gt + o) = pack8(r0, r1); }
                __builtin_amdgcn_sched_barrier(0);
            }
    } };
struct SchedP3 { char* ws; int G, c;
    __device__ __forceinline__ bool next(int i, Unit& u) const { int pm, pn; if (!tile_order((long)(i >> 3) * G + c, 64, 4, pm, pn)) return false; const int sub = i & 7, k = sub >> 1;
        if (!(sub & 1)) { u.A = ws + OFF_H + (size_t)pm * 256 * 2048; u.B = ws + OFF_WINT + (size_t)(6144 + k * 1024 + pn * 256) * 2048; u.lda2 = 2048; u.ldb2 = 2048; u.nt = 16; }
        else { const size_t yo = k == 0 ? OFF_S5G : k == 1 ? OFF_SGUU : k == 2 ? OFF_M2Z : OFF_SCB;
            u.A = ws + yo + (size_t)pm * 256 * 1024; u.B = ws + OFF_WBT + (size_t)(k * 1024 + pn * 256) * 1024; u.lda2 = 1024; u.ldb2 = 1024; u.nt = 8; }
        u.tag = sub; u.pm = pm; u.pn = pn; return true; } };
template <int KC> __device__ __forceinline__ void p3_branch_epi(const f32x4 (&acc)[2][2][4][2], char* gsb, char* psb, bf16_t* mg, const Unit& u, int wr, int wc, int fr, int fq) {
#pragma unroll
    for (int ai = 0; ai < 2; ++ai)
#pragma unroll
        for (int bj = 0; bj < 2; ++bj) {
            u32x4 pk[2], pp[4];
#pragma unroll
            for (int mp = 0; mp < 2; ++mp) pk[mp] = *(const u32x4*)(gsb + ((ai * 2 + bj) * 2 + mp) * 8192);
            if (KC > 0) {
#pragma unroll
                for (int m = 0; m < 4; ++m) pp[m] = *(const u32x4*)(psb + ((ai * 2 + bj) * 4 + m) * 8192);
            }
#pragma unroll
            for (int m = 0; m < 4; ++m) { const int slot = (ai * 2 + bj) * 4 + m; const unsigned w0 = pk[m >> 1][(m & 1) * 2], w1 = pk[m >> 1][(m & 1) * 2 + 1];
                f32x4 g0, g1;
#pragma unroll
                for (int j = 0; j < 4; ++j) { g0[j] = (float)((w0 >> (8 * j)) & 0xffu); g1[j] = (float)((w1 >> (8 * j)) & 0xffu); }
                f32x4 v0, v1;
                if (KC > 0) { f32x4 p0, p1; unpack8(pp[m], p0, p1);
#pragma unroll
                    for (int j = 0; j < 4; ++j) { v0[j] = __builtin_fmaf(g0[j], acc[ai][bj][m][0][j], p0[j]); v1[j] = __builtin_fmaf(g1[j], acc[ai][bj][m][1][j], p1[j]); } }
                else { v0 = g0 * acc[ai][bj][m][0]; v1 = g1 * acc[ai][bj][m][1]; }
                if (KC < 3) *(u32x4*)(psb + slot * 8192) = pack8(v0, v1);
                else { const int row = u.pm * 256 + ai * 128 + wr * 64 + m * 16 + fr, col = u.pn * 256 + bj * 128 + wc * 32 + 8 * fq;
                    *(u32x4*)(mg + (size_t)row * 1024 + col) = pack8(v0 * (1.0f / 255.0f), v1 * (1.0f / 255.0f)); }
            }
            __builtin_amdgcn_sched_barrier(0);
        }
}
struct EpiP3 { static constexpr bool AFTER_DRAIN = false; char* ws; const float* mb;
    __device__ __forceinline__ void operator()(const f32x4 (&acc)[2][2][4][2], const Unit& u, int, int, int, int) const {
        const int k = u.tag >> 1;
        const int tq = tidx(), wr = tq >> 8, wc = (tq >> 6) & 3, fr = tq & 15, fq = (tq >> 4) & 3;
        unsigned t16 = (unsigned)tq * 16u; asm volatile("" : "+v"(t16));
        char* gsb = ws + OFF_GS + (size_t)bidx() * (8 * 512 * 16) + t16;
        char* psb = ws + OFF_PART + (size_t)bidx() * (16 * 512 * 16) + t16;
        if (!(u.tag & 1)) {
#pragma unroll
            for (int bj = 0; bj < 2; ++bj) { const int col = u.pn * 256 + bj * 128 + wc * 32 + 8 * fq;
                const f32x4 b0 = *(const f32x4*)(mb + k * 1024 + col) * -1.4426950408889634f, b1 = *(const f32x4*)(mb + k * 1024 + col + 4) * -1.4426950408889634f;
#pragma unroll
                for (int ai = 0; ai < 2; ++ai)
#pragma unroll
                    for (int mp = 0; mp < 2; ++mp) { u32x4 pk;
#pragma unroll
                        for (int mm = 0; mm < 2; ++mm) { const int m = mp * 2 + mm; unsigned w0 = 0u, w1 = 0u;
#pragma unroll
                            for (int j = 0; j < 4; ++j) {
                                const float e0 = __builtin_amdgcn_exp2f(__builtin_fmaf(acc[ai][bj][m][0][j], -1.4426950408889634f, b0[j])), e1 = __builtin_amdgcn_exp2f(__builtin_fmaf(acc[ai][bj][m][1][j], -1.4426950408889634f, b1[j]));
                                w0 = __builtin_amdgcn_cvt_pk_u8_f32(__builtin_amdgcn_rcpf(__builtin_fmaf(e0, 1.0f / 255.0f, 1.0f / 255.0f)), j, w0);
                                w1 = __builtin_amdgcn_cvt_pk_u8_f32(__builtin_amdgcn_rcpf(__builtin_fmaf(e1, 1.0f / 255.0f, 1.0f / 255.0f)), j, w1); }
                            pk[mm * 2] = w0; pk[mm * 2 + 1] = w1; }
                        *(u32x4*)(gsb + ((ai * 2 + bj) * 2 + mp) * 8192) = pk; }
            }
        } else {
            bf16_t* mg = (bf16_t*)(ws + OFF_MERGED);
            if (k == 0) p3_branch_epi<0>(acc, gsb, psb, mg, u, wr, wc, fr, fq);
            else if (k == 3) p3_branch_epi<3>(acc, gsb, psb, mg, u, wr, wc, fr, fq);
            else p3_branch_epi<1>(acc, gsb, psb, mg, u, wr, wc, fr, fq);
        }
    } };
struct SchedP4 { char* ws; int G, c;
    __device__ __forceinline__ bool next(int i, Unit& u) const { int pm, pn; if (!tile_order((long)i * G + c, 64, 4, pm, pn)) return false;
        u.A = ws + OFF_MERGED + (size_t)pm * 256 * 2048; u.B = ws + OFF_WOUTT + (size_t)pn * 256 * 2048; u.lda2 = 2048; u.ldb2 = 2048; u.nt = 16; u.tag = 0; u.pm = pm; u.pn = pn; return true; } };
struct EpiP4 { static constexpr bool AFTER_DRAIN = false; const float* xin; float* xout;
    __device__ __forceinline__ void operator()(const f32x4 (&acc)[2][2][4][2], const Unit& u, int, int, int, int) const {
        const int tq = tidx(), wr = tq >> 8, wc = (tq >> 6) & 3, fr = tq & 15, fq = (tq >> 4) & 3;
#pragma unroll
        for (int ai = 0; ai < 2; ++ai)
#pragma unroll
            for (int bj = 0; bj < 2; ++bj) {
                f32x4 xr[4][2];
#pragma unroll
                for (int m = 0; m < 4; ++m) { const size_t o = (size_t)(u.pm * 256 + ai * 128 + wr * 64 + m * 16 + fr) * 1024 + u.pn * 256 + bj * 128 + wc * 32 + 8 * fq;
                    xr[m][0] = *(const f32x4*)(xin + o); xr[m][1] = *(const f32x4*)(xin + o + 4); }
#pragma unroll
                for (int m = 0; m < 4; ++m) { const size_t o = (size_t)(u.pm * 256 + ai * 128 + wr * 64 + m * 16 + fr) * 1024 + u.pn * 256 + bj * 128 + wc * 32 + 8 * fq;
                    *(f32x4*)(xout + o) = xr[m][0] + acc[ai][bj][m][0]; *(f32x4*)(xout + o + 4) = xr[m][1] + acc[ai][bj][m][1]; }
                __builtin_amdgcn_sched_barrier(0);
            }
    } };

constexpr int LDP = 136;
__device__ __forceinline__ bf16x8 ldfrag(const bf16_t* base, int row, int k0) { return *(const bf16x8*)(base + row * LDP + k0); }
__device__ __forceinline__ int xrow(int p) { return (p & ~7) | ((p + (p >> 3)) & 7); }
__device__ __forceinline__ f32x4 mma16(bf16x8 a, bf16x8 b, f32x4 c) { return __builtin_amdgcn_mfma_f32_16x16x32_bf16(a, b, c, 0, 0, 0); }

__device__ __forceinline__ void transpose_tile(float* tile, const float* src, size_t ldn, bf16_t* dst, size_t ldk) {
    const int tid = tidx();
    {
        const int k0 = tid >> 6, n4 = (tid & 63) * 4;
        f32x4 v[8];
#pragma unroll
        for (int j = 0; j < 8; ++j) v[j] = *(const f32x4*)(src + (size_t)(k0 + j * 8) * ldn + n4);
#pragma unroll
        for (int j = 0; j < 8; ++j) { float* t = tile + (k0 + j * 8) * 257 + n4; t[0] = v[j][0]; t[1] = v[j][1]; t[2] = v[j][2]; t[3] = v[j][3]; }
    }
    __syncthreads();
    {
        const int n = tid >> 1, kb = (tid & 1) * 32;
#pragma unroll
        for (int j = 0; j < 4; ++j) { f32x4 a, b;
#pragma unroll
            for (int e = 0; e < 4; ++e) { a[e] = tile[(kb + j * 8 + e) * 257 + n]; b[e] = tile[(kb + j * 8 + 4 + e) * 257 + n]; }
            *(u32x4*)(dst + (size_t)n * ldk + kb + j * 8) = pack8(a, b); }
    }
    __syncthreads();
}

__device__ void phase_prep_weights(const P& p, int layer, char* smem) {
    float* tile = (float*)smem;
    const float* w_in = p.w_in + (size_t)layer * 1024 * IN_DIM_;
    for (int idx = bidx(); idx < 848; idx += gdim()) {
        if (idx < 640) { const int nt = idx >> 4, kt = idx & 15; const int n0 = nt * 256, so = n0 < 4096 ? n0 : n0 + 8;
            transpose_tile(tile, w_in + (size_t)kt * 64 * IN_DIM_ + so, IN_DIM_, (bf16_t*)(p.ws + OFF_WINT) + (size_t)n0 * 1024 + kt * 64, 1024); }
        else if (idx < 768) { const int j = idx - 640, k = j >> 5, r = j & 31, dt = r >> 3, wt = r & 7;
            transpose_tile(tile, p.w_branch + ((size_t)(layer * 4 + k) * 512 + wt * 64) * 1024 + dt * 256, 1024, (bf16_t*)(p.ws + OFF_WBT) + ((size_t)k * 1024 + dt * 256) * 512 + wt * 64, 512); }
        else if (idx < 832) { const int j = idx - 768, nt = j >> 4, kt = j & 15;
            transpose_tile(tile, p.w_out + ((size_t)layer * 1024 + kt * 64) * 1024 + nt * 256, 1024, (bf16_t*)(p.ws + OFF_WOUTT) + (size_t)nt * 256 * 1024 + kt * 64, 1024); }
        else { const int j = idx - 832, nt = j >> 3, kt = j & 7;
            transpose_tile(tile, p.w_glu + ((size_t)layer * 512 + kt * 64) * 512 + nt * 256, 512, (bf16_t*)(p.ws + OFF_WGLUT) + (size_t)nt * 256 * 512 + kt * 64, 512); }
    }
}

__device__ void phase_s5_tables(const P& p, int layer, char* smem) {
    float* pwr = (float*)smem;
    float* pwi = pwr + 64 * 17;
    float* bbr = pwi + 64 * 17;
    float* bbi = bbr + 1024;
    float* cr = bbi + 1024;
    float* ci = cr + 1024;
    float* kern = ci + 1024;
    const int tid = tidx();
    for (int job = bidx(); job < 256; job += gdim()) {
        const int g = job >> 3, part = job & 7;
        const int lg = layer * 32 + g;
        if (tid < 64) {
            const int n = tid;
            const float step = expf(p.log_step[lg]);
            const float lr = p.lam_re[lg * 64 + n], li = p.lam_im[lg * 64 + n];
            const float mag = expf(lr * step); float sn, cs; sincosf(li * step, &sn, &cs);
            const float abr = mag * cs, abi = mag * sn, den = lr * lr + li * li, nr = abr - 1.0f;
            const float cre = (nr * lr + abi * li) / den, cim = (abi * lr - nr * li) / den;
            double pr = 1.0, pi = 0.0; const double ar = (double)abr, ai = (double)abi;
            for (int j = 0; j <= 16; ++j) { pwr[n * 17 + j] = (float)pr; pwi[n * 17 + j] = (float)pi; const double t0 = pr * ar - pi * ai, t1 = pr * ai + pi * ar; pr = t0; pi = t1; }
            if (part == 0) { float* aq = (float*)(p.ws + OFF_AQ) + (g * 64 + n) * 2; aq[0] = pwr[n * 17 + 16]; aq[1] = pwi[n * 17 + 16]; }
            for (int q = 0; q < 16; ++q) { const float br = p.b_re[((size_t)lg * 64 + n) * 16 + q], bi = p.b_im[((size_t)lg * 64 + n) * 16 + q];
                bbr[n * 16 + q] = cre * br - cim * bi; bbi[n * 16 + q] = cre * bi + cim * br; }
        }
        for (int i = tid; i < 1024; i += 512) { cr[i] = p.c_re[(size_t)lg * 1024 + i]; ci[i] = p.c_im[(size_t)lg * 1024 + i]; }
        __syncthreads();
        const int nlag = 2 * part + 2;
        for (int o = tid; o < nlag * 64; o += 512) { const int j = o >> 6, pp = (o >> 2) & 15, q4 = (o & 3) * 4; f32x4 s4 = (f32x4){0.f, 0.f, 0.f, 0.f};
            for (int n = 0; n < 64; ++n) { const float wr_ = pwr[n * 17 + j], wi_ = pwi[n * 17 + j], c_r = cr[pp * 64 + n], c_i = ci[pp * 64 + n];
                const float dr_ = c_r * wr_ - c_i * wi_, di_ = c_r * wi_ + c_i * wr_;
                const f32x4 br = *(const f32x4*)(bbr + n * 16 + q4), bi = *(const f32x4*)(bbi + n * 16 + q4);
                s4 += dr_ * br - di_ * bi; }
            *(f32x4*)(kern + j * 256 + pp * 16 + q4) = s4; }
        __syncthreads();
        bf16_t* b2 = (bf16_t*)(p.ws + OFF_B2TAB) + (size_t)g * 256 * 384;
        for (int i = tid; i < 32 * 384; i += 512) { const int idx = part * 32 * 384 + i; const int r = idx / 384, k = idx - r * 384, t = r >> 4, pp = r & 15; float v;
            if (k < 64) v = cr[pp * 64 + k] * pwr[k * 17 + t + 1] - ci[pp * 64 + k] * pwi[k * 17 + t + 1];
            else if (k < 128) { const int n = k - 64; v = -(cr[pp * 64 + n] * pwi[n * 17 + t + 1] + ci[pp * 64 + n] * pwr[n * 17 + t + 1]); }
            else { const int s_ = (k - 128) >> 4, q = (k - 128) & 15; v = s_ <= t ? kern[(t - s_) * 256 + pp * 16 + q] : 0.f; }
            b2[idx] = f2bf(v); }
        bf16_t* gt = (bf16_t*)(p.ws + OFF_GTAB) + (size_t)g * 128 * 256;
        for (int i = tid; i < 16 * 256; i += 512) { const int idx = part * 16 * 256 + i; const int np = idx >> 8, kk = idx & 255, s_ = kk >> 4, q = kk & 15, n = np & 63;
            const float wr_ = pwr[n * 17 + 15 - s_], wi_ = pwi[n * 17 + 15 - s_], br = bbr[n * 16 + q], bi = bbi[n * 16 + q];
            gt[idx] = f2bf(np < 64 ? (wr_ * br - wi_ * bi) : (wr_ * bi + wi_ * br)); }
        if (g == 31) { bf16_t* pad = (bf16_t*)(p.ws + OFF_GTAB) + (size_t)32 * 128 * 256 + part * 16 * 256; for (int i = tid; i < 16 * 256; i += 512) pad[i] = 0; }
        __syncthreads();
    }
}

__device__ __forceinline__ float wave_sum(float v) {
#pragma unroll
    for (int o = 32; o > 0; o >>= 1) v += __shfl_xor(v, o, 64);
    return v;
}

__device__ void phase_rmsnorm_h(const P& p, int layer, const float* xin, char* smem) {
    const int tid = tidx(), wid = tid >> 6, lane = tid & 63;
    const float* w_in = p.w_in + (size_t)layer * 1024 * IN_DIM_;
    f32x4 wq[16][2];
#pragma unroll
    for (int j = 0; j < 4; ++j)
#pragma unroll
        for (int e = 0; e < 4; ++e) { const size_t k = (size_t)(j * 256 + lane * 4 + e); wq[j * 4 + e][0] = *(const f32x4*)(w_in + k * IN_DIM_ + 4096); wq[j * 4 + e][1] = *(const f32x4*)(w_in + k * IN_DIM_ + 4100); }
    const float* nw = p.norm_w + layer * 1024;
    bf16_t* h = (bf16_t*)(p.ws + OFF_H); float* dtraw = (float*)(p.ws + OFF_DTRAW);
    f32x4 wv[4];
#pragma unroll
    for (int j = 0; j < 4; ++j) wv[j] = *(const f32x4*)(nw + j * 256 + lane * 4);
    for (int row0 = (bidx() * 8 + wid) * 2; row0 < T_; row0 += gdim() * 16) {
        f32x4 v[2][4]; float ss[2] = {0.f, 0.f};
#pragma unroll
        for (int r = 0; r < 2; ++r)
#pragma unroll
            for (int j = 0; j < 4; ++j) v[r][j] = *(const f32x4*)(xin + (size_t)(row0 + r) * 1024 + j * 256 + lane * 4);
#pragma unroll
        for (int r = 0; r < 2; ++r)
#pragma unroll
            for (int j = 0; j < 4; ++j) ss[r] += v[r][j][0] * v[r][j][0] + v[r][j][1] * v[r][j][1] + v[r][j][2] * v[r][j][2] + v[r][j][3] * v[r][j][3];
        ss[0] = wave_sum(ss[0]); ss[1] = wave_sum(ss[1]);
#pragma unroll
        for (int r = 0; r < 2; ++r) {
            const float rstd = rsqrtf(ss[r] * (1.0f / 1024.0f) + 1e-6f);
            float dacc[8];
#pragma unroll
            for (int e = 0; e < 8; ++e) dacc[e] = 0.f;
#pragma unroll
            for (int j = 0; j < 4; ++j) { const f32x4 hv = v[r][j] * rstd * wv[j];
                u32x2 o; o[0] = cvt_pk_bf16(hv[0], hv[1]); o[1] = cvt_pk_bf16(hv[2], hv[3]);
                *(u32x2*)(h + (size_t)(row0 + r) * 1024 + j * 256 + lane * 4) = o;
#pragma unroll
                for (int e = 0; e < 4; ++e) { const f32x4 w0 = wq[j * 4 + e][0], w1 = wq[j * 4 + e][1];
#pragma unroll
                    for (int q = 0; q < 4; ++q) { dacc[q] += hv[e] * w0[q]; dacc[4 + q] += hv[e] * w1[q]; } }
            }
            const bool h32 = (lane & 32) != 0, h16 = (lane & 16) != 0, h8 = (lane & 8) != 0;
            float a4[4];
#pragma unroll
            for (int e = 0; e < 4; ++e) { const float send = h32 ? dacc[e] : dacc[4 + e]; const float keep = h32 ? dacc[4 + e] : dacc[e]; a4[e] = keep + __shfl_xor(send, 32, 64); }
            float a2[2];
#pragma unroll
            for (int e = 0; e < 2; ++e) { const float send = h16 ? a4[e] : a4[2 + e]; const float keep = h16 ? a4[2 + e] : a4[e]; a2[e] = keep + __shfl_xor(send, 16, 64); }
            float a1; { const float send = h8 ? a2[0] : a2[1]; const float keep = h8 ? a2[1] : a2[0]; a1 = keep + __shfl_xor(send, 8, 64); }
            a1 += __shfl_xor(a1, 4, 64); a1 += __shfl_xor(a1, 2, 64); a1 += __shfl_xor(a1, 1, 64);
            if ((lane & 7) == 0) { const int e = (h32 ? 4 : 0) + (h16 ? 2 : 0) + (h8 ? 1 : 0); dtraw[(size_t)(row0 + r) * 8 + e] = a1; }
        }
    }
    __syncthreads();
}

__device__ void phase_final_norm(const P& p) {
    const int tid = tidx(), wid = tid >> 6, lane = tid & 63;
    f32x4 wv[4];
#pragma unroll
    for (int j = 0; j < 4; ++j) wv[j] = *(const f32x4*)(p.final_w + j * 256 + lane * 4);
    const int rstep = gdim() * 16;
    f32x4 vn[2][4];
    { const int r0_ = (bidx() * 8 + wid) * 2;
#pragma unroll
        for (int r = 0; r < 2; ++r)
#pragma unroll
            for (int j = 0; j < 4; ++j) vn[r][j] = *(const f32x4*)(p.out + (size_t)(r0_ + r) * 1024 + j * 256 + lane * 4); }
    for (int row0 = (bidx() * 8 + wid) * 2; row0 < T_; row0 += rstep) {
        f32x4 v[2][4]; float ss[2] = {0.f, 0.f};
#pragma unroll
        for (int r = 0; r < 2; ++r)
#pragma unroll
            for (int j = 0; j < 4; ++j) v[r][j] = vn[r][j];
        { const int rn = row0 + rstep < T_ ? row0 + rstep : row0;
#pragma unroll
            for (int r = 0; r < 2; ++r)
#pragma unroll
                for (int j = 0; j < 4; ++j) vn[r][j] = *(const f32x4*)(p.out + (size_t)(rn + r) * 1024 + j * 256 + lane * 4); }
#pragma unroll
        for (int r = 0; r < 2; ++r)
#pragma unroll
            for (int j = 0; j < 4; ++j) ss[r] += v[r][j][0] * v[r][j][0] + v[r][j][1] * v[r][j][1] + v[r][j][2] * v[r][j][2] + v[r][j][3] * v[r][j][3];
        ss[0] = wave_sum(ss[0]); ss[1] = wave_sum(ss[1]);
#pragma unroll
        for (int r = 0; r < 2; ++r) { const float rstd = rsqrtf(ss[r] * (1.0f / 1024.0f) + 1e-6f);
#pragma unroll
            for (int j = 0; j < 4; ++j) *(f32x4*)(p.out + (size_t)(row0 + r) * 1024 + j * 256 + lane * 4) = v[r][j] * rstd * wv[j]; }
    }
}

__device__ void phase_sgu(const P& p, int layer, char* smem, int task0, int tstride) {
    bf16_t* vnT = (bf16_t*)smem;
    float* hs = (float*)(smem + 8 * 64 * LDP * 2);
    float* rs = hs + 8 * 128 * 2;
    const int tid = tidx(), w = tid >> 6, lane = tid & 63;
    const bf16_t* vbuf = (const bf16_t*)(p.ws + OFF_SGUV); const bf16_t* gbuf = (const bf16_t*)(p.ws + OFF_SGUG); bf16_t* ubuf = (bf16_t*)(p.ws + OFF_SGUU);
    const float* lnw = p.ln_w + layer * 512 + w * 64; const float* lnb = p.ln_b + layer * 512 + w * 64;
    const float* Wm = p.sgu_w + ((size_t)layer * 8 + w) * 128 * 128; const float* bs = p.sgu_b + (layer * 8 + w) * 128;
    for (int task = task0; task < 128; task += tstride) {
        const size_t tok0 = (size_t)task * 128;
        const int r8 = lane >> 3, e0 = (lane & 7) * 8;
        bf16_t* my = vnT + (size_t)w * 64 * LDP;
#pragma unroll 1
        for (int hb = 0; hb < 2; ++hb) {
        u32x4 vraw[8];
#pragma unroll
        for (int it = 0; it < 8; ++it) vraw[it] = *(const u32x4*)(vbuf + (tok0 + (hb * 8 + it) * 8 + r8) * 512 + w * 64 + e0);
#pragma unroll
        for (int it = 0; it < 8; ++it) { const int s = (hb * 8 + it) * 8 + r8;
            f32x4 a, b; unpack8(vraw[it], a, b);
            float sm = 0.f, sq = 0.f;
#pragma unroll
            for (int j = 0; j < 4; ++j) { const float x0 = geluf_(a[j]), x1 = geluf_(b[j]); sm += x0 + x1; sq += x0 * x0 + x1 * x1;
                my[xrow(e0 + j) * LDP + s] = f2bf(x0); my[xrow(e0 + 4 + j) * LDP + s] = f2bf(x1); }
#pragma unroll
            for (int o = 1; o < 8; o <<= 1) { sm += __shfl_xor(sm, o, 64); sq += __shfl_xor(sq, o, 64); }
            if ((lane & 7) == 0) { hs[(w * 128 + s) * 2] = sm; hs[(w * 128 + s) * 2 + 1] = sq; }
        }
        }
        __syncthreads();
        if (tid < 128) { float sm = 0.f, sq = 0.f;
#pragma unroll
            for (int hh = 0; hh < 8; ++hh) { sm += hs[(hh * 128 + tid) * 2]; sq += hs[(hh * 128 + tid) * 2 + 1]; }
            const float mu = sm * (1.0f / 512.0f); const float var = fmaxf(sq * (1.0f / 512.0f) - mu * mu, 0.f);
            rs[tid * 2] = mu; rs[tid * 2 + 1] = rsqrtf(var + 1e-6f); }
        __syncthreads();
        {
            const f32x4 lw0 = *(const f32x4*)(lnw + e0), lw1 = *(const f32x4*)(lnw + e0 + 4), lb0 = *(const f32x4*)(lnb + e0), lb1 = *(const f32x4*)(lnb + e0 + 4);
#pragma unroll 4
            for (int it = 0; it < 16; ++it) { const int s = it * 8 + r8;
                const float mu = rs[s * 2], rstd = rs[s * 2 + 1];
#pragma unroll
                for (int j = 0; j < 4; ++j) { bf16_t* q0 = my + xrow(e0 + j) * LDP + s; bf16_t* q1 = my + xrow(e0 + 4 + j) * LDP + s;
                    *q0 = f2bf((bf2f(*q0) - mu) * rstd * lw0[j] + lb0[j]); *q1 = f2bf((bf2f(*q1) - mu) * rstd * lw1[j] + lb1[j]); }
            }
        }
        __syncthreads();
        {
            const int fr = lane & 15, kq = lane >> 4;
            f32x4 wq[4][2]; u32x2 uq[4], gq[4]; float btq;
#define SGU_LOAD(NT) do { const int t_ = (NT) * 16 + fr; \
                _Pragma("unroll") for (int ks = 0; ks < 4; ++ks) { wq[ks][0] = *(const f32x4*)(Wm + (size_t)t_ * 128 + ks * 32 + kq * 8); wq[ks][1] = *(const f32x4*)(Wm + (size_t)t_ * 128 + ks * 32 + kq * 8 + 4); } \
                _Pragma("unroll") for (int mt = 0; mt < 4; ++mt) { const size_t o_ = (tok0 + t_) * 512 + w * 64 + mt * 16 + kq * 4; uq[mt] = *(const u32x2*)(ubuf + o_); gq[mt] = *(const u32x2*)(gbuf + o_); } \
                btq = bs[t_]; } while (0)
            SGU_LOAD(0);
#pragma unroll 1
            for (int nt = 0; nt < 8; ++nt) {
                f32x4 acc[4];
#pragma unroll
                for (int mt = 0; mt < 4; ++mt) acc[mt] = (f32x4){0.f, 0.f, 0.f, 0.f};
                const int t = nt * 16 + fr;
                bf16x8 bfr[4];
#pragma unroll
                for (int ks = 0; ks < 4; ++ks) { const int s0 = ks * 32 + kq * 8; f32x4 m0, m1;
#pragma unroll
                    for (int j = 0; j < 4; ++j) { m0[j] = (s0 + j <= t) ? wq[ks][0][j] : 0.f; m1[j] = (s0 + 4 + j <= t) ? wq[ks][1][j] : 0.f; }
                    const u32x4 bw = pack8(m0, m1); bfr[ks] = *(const bf16x8*)&bw; }
                u32x2 uc[4], gc[4]; const float bt = btq;
#pragma unroll
                for (int mt = 0; mt < 4; ++mt) { uc[mt] = uq[mt]; gc[mt] = gq[mt]; }
                if (nt < 7) SGU_LOAD(nt + 1);
#pragma unroll
                for (int ks = 0; ks < 4; ++ks) if (ks <= (nt >> 1)) {
                    const int s0 = ks * 32 + kq * 8;
#pragma unroll
                    for (int mt = 0; mt < 4; ++mt) acc[mt] = mma16(ldfrag(my, xrow(mt * 16 + fr), s0), bfr[ks], acc[mt]);
                }
                const size_t tok = tok0 + t;
#pragma unroll
                for (int mt = 0; mt < 4; ++mt) { const size_t o = tok * 512 + w * 64 + mt * 16 + kq * 4;
                    const u32x2 uu = uc[mt], gg = gc[mt];
                    const float u0 = bflo(uu[0]), u1 = bfhi(uu[0]), u2 = bflo(uu[1]), u3 = bfhi(uu[1]);
                    const float g0 = bflo(gg[0]), g1 = bfhi(gg[0]), g2 = bflo(gg[1]), g3 = bfhi(gg[1]);
                    u32x2 r; r[0] = cvt_pk_bf16(u0 * g0 * (acc[mt][0] + bt) * sig2f_(geluarg_(u0), g0), u1 * g1 * (acc[mt][1] + bt) * sig2f_(geluarg_(u1), g1));
                    r[1] = cvt_pk_bf16(u2 * g2 * (acc[mt][2] + bt) * sig2f_(geluarg_(u2), g2), u3 * g3 * (acc[mt][3] + bt) * sig2f_(geluarg_(u3), g3));
                    *(u32x2*)(ubuf + o) = r; }
            }
#undef SGU_LOAD
        }
        __syncthreads();
    }
}

__device__ void phase_m2_local(const P& p, int layer, char* smem) {
    bf16_t* Cs = (bf16_t*)smem;
    bf16_t* Bs = Cs + 128 * LDP;
    bf16_t* BTs = Bs + 128 * LDP;
    bf16_t* xT = BTs + 128 * LDP;
    float* dts4 = (float*)(xT + 64 * LDP);
    float* acs4 = dts4 + 512;
    float* das4 = acs4 + 512;
    const int tid = tidx(), w = tid >> 6, lane = tid & 63, fr = lane & 15, kq = lane >> 4;
    const bf16_t* xbc = (const bf16_t*)(p.ws + OFF_XBC); const float* dtraw = (const float*)(p.ws + OFF_DTRAW);
    const float* cw = p.conv_w + (size_t)layer * 4 * 1024; const float* cbv = p.conv_b + layer * 1024;
    for (int task = bidx(); task < 256; task += gdim()) {
        const int grp = task & 1, c = (task >> 1) & 15, b = task >> 5;
        const size_t tok0 = (size_t)b * SEQ_ + c * 128;
        {
            const int h4 = tid >> 7, l = tid & 127, hd = grp * 4 + h4;
            const float aneg = -__expf(p.a_log[layer * 8 + hd]);
            const float dr = dtraw[(tok0 + l) * 8 + hd] + p.dt_bias[layer * 8 + hd]; const float e_ = __expf(dr), u_ = 1.0f + e_; const float dt = dr > 20.f ? dr : (u_ == 1.0f ? e_ : __logf(u_) * e_ * __builtin_amdgcn_rcpf(u_ - 1.0f));
            dts4[tid] = dt; das4[tid] = dt * aneg;
            float s_ = dt * aneg;
#pragma unroll
            for (int o = 1; o < 64; o <<= 1) { const float t = __shfl_up(s_, o, 64); if ((tid & 63) >= o) s_ += t; }
            __syncthreads();
            if (l >= 64) { float tot = 0.f; const float* dh = das4 + h4 * 128;
                for (int j = 0; j < 64; j += 4) tot += dh[j] + dh[j + 1] + dh[j + 2] + dh[j + 3];
                s_ += tot; }
            acs4[tid] = s_;
            ((float*)(p.ws + OFF_EACS))[(tok0 + l) * 8 + hd] = __expf(s_);
            if (l == 127) ((float*)(p.ws + OFF_ACH))[(b * 16 + c) * 8 + hd] = s_;
        }
        {
            const int cgi = tid & 31, run = tid >> 5, l0 = run * 8;
            const int ch = cgi < 16 ? 512 + grp * 128 + cgi * 8 : 768 + grp * 128 + (cgi - 16) * 8, n0 = (cgi & 15) * 8;
            f32x4 wk[4][2], bias0 = *(const f32x4*)(cbv + ch), bias1 = *(const f32x4*)(cbv + ch + 4);
#pragma unroll
            for (int k = 0; k < 4; ++k) { wk[k][0] = *(const f32x4*)(cw + k * 1024 + ch); wk[k][1] = *(const f32x4*)(cw + k * 1024 + ch + 4); }
            f32x4 h0[3], h1[3];
#pragma unroll
            for (int j = 0; j < 3; ++j) { const int l = l0 - 3 + j; const bool ok = c * 128 + l >= 0;
                u32x4 rw = *(const u32x4*)(xbc + (tok0 + (ok ? l : 0)) * 1024 + ch); if (!ok) rw = (u32x4){0u, 0u, 0u, 0u};
                unpack8(rw, h0[j], h1[j]); }
#pragma unroll 1
            for (int hb = 0; hb < 2; ++hb) {
            u32x4 raw[4];
#pragma unroll
            for (int i = 0; i < 4; ++i) raw[i] = *(const u32x4*)(xbc + (tok0 + l0 + hb * 4 + i) * 1024 + ch);
#pragma unroll
            for (int i = 0; i < 4; ++i) { const int l = l0 + hb * 4 + i;
                f32x4 c0, c1; unpack8(raw[i], c0, c1);
                f32x4 o0 = bias0 + wk[0][0] * h0[0] + wk[1][0] * h0[1] + wk[2][0] * h0[2] + wk[3][0] * c0;
                f32x4 o1 = bias1 + wk[0][1] * h1[0] + wk[1][1] * h1[1] + wk[2][1] * h1[2] + wk[3][1] * c1;
                h0[0] = h0[1]; h0[1] = h0[2]; h0[2] = c0; h1[0] = h1[1]; h1[1] = h1[2]; h1[2] = c1;
#pragma unroll
                for (int j = 0; j < 4; ++j) { o0[j] = siluf_(o0[j]); o1[j] = siluf_(o1[j]); }
                const u32x4 pk = pack8(o0, o1);
                if (cgi < 16) *(u32x4*)(Bs + l * LDP + n0) = pk;
                else { *(u32x4*)(Cs + l * LDP + n0) = pk; *(u32x4*)((bf16_t*)(p.ws + OFF_CCONV) + (tok0 + l) * 256 + grp * 128 + n0) = pk; }
            }
            }
        }
        __syncthreads();
        const int ntile = (w | 1) + 1;
        u32x2 g16[8];
        {
            f32x4 g[8];
#pragma unroll
            for (int st = 0; st < 8; ++st) g[st] = (f32x4){0.f, 0.f, 0.f, 0.f};
#pragma unroll
            for (int ks = 0; ks < 4; ++ks) { const bf16x8 a = ldfrag(Cs, w * 16 + fr, ks * 32 + kq * 8);
#pragma unroll
                for (int st = 0; st < 8; ++st) if (st < ntile) g[st] = mma16(a, ldfrag(Bs, st * 16 + fr, ks * 32 + kq * 8), g[st]); }
#pragma unroll
            for (int st = 0; st < 8; ++st) { g16[st][0] = cvt_pk_bf16(g[st][0], g[st][1]); g16[st][1] = cvt_pk_bf16(g[st][2], g[st][3]); }
        }
#pragma unroll 1
        for (int h4 = 0; h4 < 4; ++h4) {
            const int hd = grp * 4 + h4;
            const float* dts = dts4 + h4 * 128; const float* acs = acs4 + h4 * 128;
            __syncthreads();
            const float alast = acs[127];
            {
                const int cgx = tid & 7, run = tid >> 3, l0 = run * 2, ch = hd * 64 + cgx * 8, p0 = cgx * 8;
                f32x4 wk[4][2], bias0 = *(const f32x4*)(cbv + ch), bias1 = *(const f32x4*)(cbv + ch + 4);
#pragma unroll
                for (int k = 0; k < 4; ++k) { wk[k][0] = *(const f32x4*)(cw + k * 1024 + ch); wk[k][1] = *(const f32x4*)(cw + k * 1024 + ch + 4); }
                f32x4 r0[5], r1[5];
#pragma unroll
                for (int j = 0; j < 5; ++j) { const int l = l0 - 3 + j; const bool ok = c * 128 + l >= 0;
                    u32x4 rw = *(const u32x4*)(xbc + (tok0 + (ok ? l : 0)) * 1024 + ch); if (!ok) rw = (u32x4){0u, 0u, 0u, 0u};
                    unpack8(rw, r0[j], r1[j]); }
#pragma unroll
                for (int i = 0; i < 2; ++i) { const int l = l0 + i;
                    f32x4 o0 = bias0 + wk[0][0] * r0[i] + wk[1][0] * r0[i + 1] + wk[2][0] * r0[i + 2] + wk[3][0] * r0[i + 3];
                    f32x4 o1 = bias1 + wk[0][1] * r1[i] + wk[1][1] * r1[i + 1] + wk[2][1] * r1[i + 2] + wk[3][1] * r1[i + 3];
#pragma unroll
                    for (int j = 0; j < 4; ++j) { xT[(p0 + j) * LDP + l] = f2bf(siluf_(o0[j])); xT[(p0 + 4 + j) * LDP + l] = f2bf(siluf_(o1[j])); } }
            }
#pragma unroll
            for (int i = 0; i < 4; ++i) { const int pr = tid + i * 512, l = pr & 127, n0 = (pr >> 7) * 8;
                f32x4 b0, b1; unpack8(*(const u32x4*)(Bs + l * LDP + n0), b0, b1);
                const float sc = dts[l] * __expf(alast - acs[l]);
#pragma unroll
                for (int j = 0; j < 4; ++j) { BTs[(n0 + j) * LDP + l] = f2bf(b0[j] * sc); BTs[(n0 + 4 + j) * LDP + l] = f2bf(b1[j] * sc); } }
#pragma unroll
            for (int st = 0; st < 8; ++st) if (st < ntile) { const int s_ = st * 16 + fr; const float as_ = acs[s_], ds_ = dts[s_];
#pragma unroll
                for (int r = 0; r < 4; ++r) { const int l = w * 16 + kq * 4 + r; const float gv = (r & 1) ? bfhi(g16[st][r >> 1]) : bflo(g16[st][r >> 1]); const float v = (s_ <= l) ? gv * __expf(acs[l] - as_) * ds_ : 0.f; Cs[l * LDP + s_] = f2bf(v); } }
            __syncthreads();
            {
                f32x4 y[4];
#pragma unroll
                for (int mt = 0; mt < 4; ++mt) y[mt] = (f32x4){0.f, 0.f, 0.f, 0.f};
                for (int ks = 0; ks <= (w >> 1); ++ks) { const bf16x8 bfrag = ldfrag(Cs, w * 16 + fr, ks * 32 + kq * 8);
#pragma unroll
                    for (int mt = 0; mt < 4; ++mt) y[mt] = mma16(ldfrag(xT, mt * 16 + fr, ks * 32 + kq * 8), bfrag, y[mt]); }
                const int l = w * 16 + fr; const float dd = p.m2_d[layer * 8 + hd];
                bf16_t* yp = (bf16_t*)(p.ws + OFF_YPART) + (tok0 + l) * 512 + hd * 64;
#pragma unroll
                for (int mt = 0; mt < 4; ++mt) { const int p0 = mt * 16 + kq * 4; f32x4 v;
#pragma unroll
                    for (int r = 0; r < 4; ++r) v[r] = y[mt][r] + dd * bf2f(xT[(p0 + r) * LDP + l]);
                    u32x2 o; o[0] = cvt_pk_bf16(v[0], v[1]); o[1] = cvt_pk_bf16(v[2], v[3]); *(u32x2*)(yp + p0) = o; }
            }
            {
                f32x4 st_[4];
#pragma unroll
                for (int pt = 0; pt < 4; ++pt) st_[pt] = (f32x4){0.f, 0.f, 0.f, 0.f};
#pragma unroll
                for (int ks = 0; ks < 4; ++ks) { const bf16x8 a = ldfrag(BTs, w * 16 + fr, ks * 32 + kq * 8);
#pragma unroll
                    for (int pt = 0; pt < 4; ++pt) st_[pt] = mma16(a, ldfrag(xT, pt * 16 + fr, ks * 32 + kq * 8), st_[pt]); }
                bf16_t* sb = (bf16_t*)(p.ws + OFF_M2ST) + (size_t)((b * 16 + c) * 8 + hd) * 64 * 128;
#pragma unroll
                for (int pt = 0; pt < 4; ++pt) { const int pp = pt * 16 + fr, n0 = w * 16 + kq * 4;
                    u32x2 o; o[0] = cvt_pk_bf16(st_[pt][0], st_[pt][1]); o[1] = cvt_pk_bf16(st_[pt][2], st_[pt][3]); *(u32x2*)(sb + pp * 128 + n0) = o; }
            }
        }
        __syncthreads();
    }
}

__device__ __forceinline__ void phase_m2_carry(const P& p, int vb, int nvb) {
    const int tid = tidx();
    for (int idx = vb * 512 + tid; idx < 8 * 8 * 64 * 32; idx += nvb * 512) {
        const int n4 = idx & 31, pp = (idx >> 5) & 63, hd = (idx >> 11) & 7, b = idx >> 14;
        bf16_t* base = (bf16_t*)(p.ws + OFF_M2ST) + (size_t)(b * 16 * 8 + hd) * 8192 + pp * 128 + n4 * 4;
        const float* ach = (const float*)(p.ws + OFF_ACH) + b * 16 * 8 + hd;
        u32x2 ld[16];
#pragma unroll
        for (int c = 0; c < 16; ++c) ld[c] = *(const u32x2*)(base + (size_t)c * 8 * 8192);
        float decq[16];
#pragma unroll
        for (int c = 0; c < 16; ++c) decq[c] = ach[c * 8];
        f32x4 S = (f32x4){0.f, 0.f, 0.f, 0.f};
#pragma unroll
        for (int c = 0; c < 16; ++c) { u32x2 o; o[0] = cvt_pk_bf16(S[0], S[1]); o[1] = cvt_pk_bf16(S[2], S[3]); *(u32x2*)(base + (size_t)c * 8 * 8192) = o;
            const float dec = __expf(decq[c]);
            S[0] = dec * S[0] + bflo(ld[c][0]); S[1] = dec * S[1] + bfhi(ld[c][0]); S[2] = dec * S[2] + bflo(ld[c][1]); S[3] = dec * S[3] + bfhi(ld[c][1]); }
    }
}
__device__ void s5_carry_unit(const P& p, char* smem, int g, int pm) {
    const int tid = tidx();
    float* ex = (float*)(smem + 65536);
    const bf16_t* sloc = (const bf16_t*)smem;
    __syncthreads();
    for (int bb = 0; bb < 2; ++bb) {
        const int b = pm * 2 + bb, n = tid & 63, seg = tid >> 6;
        const float aqr = ((const float*)(p.ws + OFF_AQ))[(g * 64 + n) * 2], aqi = ((const float*)(p.ws + OFF_AQ))[(g * 64 + n) * 2 + 1];
        const bf16_t* sl = sloc + (bb * 128 + seg * 16) * 128;
        bf16_t* a2 = (bf16_t*)(p.ws + OFF_A2) + ((size_t)g * 1024 + b * 128 + seg * 16) * 384;
        float lr[16], li[16];
#pragma unroll
        for (int j = 0; j < 16; ++j) { lr[j] = bf2f(sl[j * 128 + n]); li[j] = bf2f(sl[j * 128 + 64 + n]); }
        float sr = 0.f, si = 0.f;
#pragma unroll
        for (int j = 0; j < 16; ++j) { const float t0 = aqr * sr - aqi * si + lr[j], t1 = aqr * si + aqi * sr + li[j]; sr = t0; si = t1; }
        __syncthreads();
        ex[(seg * 64 + n) * 2] = sr; ex[(seg * 64 + n) * 2 + 1] = si;
        __syncthreads();
        float pr = aqr, pi = aqi;
#pragma unroll
        for (int j = 0; j < 4; ++j) { const float t0 = pr * pr - pi * pi, t1 = 2.f * pr * pi; pr = t0; pi = t1; }
        float cr_ = 0.f, ci_ = 0.f;
        for (int s_ = 0; s_ < seg; ++s_) { const float er = ex[(s_ * 64 + n) * 2], ei = ex[(s_ * 64 + n) * 2 + 1]; const float t0 = pr * cr_ - pi * ci_ + er, t1 = pr * ci_ + pi * cr_ + ei; cr_ = t0; ci_ = t1; }
        sr = cr_; si = ci_;
#pragma unroll
        for (int j = 0; j < 16; ++j) { a2[j * 384 + n] = f2bf(sr); a2[j * 384 + 64 + n] = f2bf(si);
            const float t0 = aqr * sr - aqi * si + lr[j], t1 = aqr * si + aqi * sr + li[j]; sr = t0; si = t1; }
    }
    asm volatile("s_waitcnt vmcnt(0)" ::: "memory");
    __syncthreads();
}

__device__ void phase_m2_out(const P& p, int layer, char* smem) {
    float* ssq = (float*)smem;
    float* rst = ssq + 512;
    const int tid = tidx(), w = tid >> 6, lane = tid & 63, fr = lane & 15, kq = lane >> 4, grp = w >> 2;
    const bf16_t* cc = (const bf16_t*)(p.ws + OFF_CCONV); const bf16_t* yp = (const bf16_t*)(p.ws + OFF_YPART); bf16_t* zb = (bf16_t*)(p.ws + OFF_M2Z);
    const float* eacs = (const float*)(p.ws + OFF_EACS); const float* nw = p.m2_norm_w + layer * 512 + w * 64;
    for (int task = bidx(); task < 256; task += gdim()) {
        const int half = task & 1, c = (task >> 1) & 15, b = task >> 5;
        const size_t tok0 = (size_t)b * SEQ_ + c * 128 + half * 64;
        const bf16_t* sin_ = (const bf16_t*)(p.ws + OFF_M2ST) + (size_t)((b * 16 + c) * 8 + w) * 8192;
        f32x4 acc[4][4];
#pragma unroll
        for (int mt = 0; mt < 4; ++mt)
#pragma unroll
            for (int nt = 0; nt < 4; ++nt) acc[mt][nt] = (f32x4){0.f, 0.f, 0.f, 0.f};
#pragma unroll
        for (int ks = 0; ks < 4; ++ks) { bf16x8 a[4];
#pragma unroll
            for (int mt = 0; mt < 4; ++mt) a[mt] = *(const bf16x8*)(sin_ + (mt * 16 + fr) * 128 + ks * 32 + kq * 8);
#pragma unroll
            for (int nt = 0; nt < 4; ++nt) { const bf16x8 bb = *(const bf16x8*)(cc + (tok0 + nt * 16 + fr) * 256 + grp * 128 + ks * 32 + kq * 8);
#pragma unroll
                for (int mt = 0; mt < 4; ++mt) acc[mt][nt] = mma16(a[mt], bb, acc[mt][nt]); } }
        u32x2 yq[4][4], zq[4][4]; float eaq[4];
#pragma unroll
        for (int nt = 0; nt < 4; ++nt) { const size_t tok = tok0 + nt * 16 + fr; eaq[nt] = eacs[tok * 8 + w];
#pragma unroll
            for (int mt = 0; mt < 4; ++mt) { const size_t o = tok * 512 + w * 64 + mt * 16 + kq * 4; yq[nt][mt] = *(const u32x2*)(yp + o); zq[nt][mt] = *(const u32x2*)(zb + o); } }
#pragma unroll
        for (int nt = 0; nt < 4; ++nt) { const float ea = eaq[nt]; float ss = 0.f;
#pragma unroll
            for (int mt = 0; mt < 4; ++mt) {
                const u32x2 yy = yq[nt][mt], zz = zq[nt][mt];
                f32x4 v; v[0] = (bflo(yy[0]) + ea * acc[mt][nt][0]) * siluf_(bflo(zz[0])); v[1] = (bfhi(yy[0]) + ea * acc[mt][nt][1]) * siluf_(bfhi(zz[0]));
                v[2] = (bflo(yy[1]) + ea * acc[mt][nt][2]) * siluf_(bflo(zz[1])); v[3] = (bfhi(yy[1]) + ea * acc[mt][nt][3]) * siluf_(bfhi(zz[1]));
                acc[mt][nt] = v; ss += v[0] * v[0] + v[1] * v[1] + v[2] * v[2] + v[3] * v[3]; }
            ss += __shfl_xor(ss, 16, 64); ss += __shfl_xor(ss, 32, 64);
            if (kq == 0) ssq[w * 64 + nt * 16 + fr] = ss; }
        __syncthreads();
        if (tid < 64) { float s = 0.f;
#pragma unroll
            for (int hh = 0; hh < 8; ++hh) s += ssq[hh * 64 + tid];
            rst[tid] = rsqrtf(s * (1.0f / 512.0f) + 1e-6f); }
        __syncthreads();
        f32x4 wvn[4];
#pragma unroll
        for (int mt = 0; mt < 4; ++mt) wvn[mt] = *(const f32x4*)(nw + mt * 16 + kq * 4);
#pragma unroll
        for (int nt = 0; nt < 4; ++nt) { const size_t tok = tok0 + nt * 16 + fr; const float r = rst[nt * 16 + fr];
#pragma unroll
            for (int mt = 0; mt < 4; ++mt) { const int p0 = mt * 16 + kq * 4; const f32x4 v = acc[mt][nt] * r * wvn[mt];
                u32x2 o; o[0] = cvt_pk_bf16(v[0], v[1]); o[1] = cvt_pk_bf16(v[2], v[3]); *(u32x2*)(zb + tok * 512 + w * 64 + p0) = o; } }
        __syncthreads();
    }
}

__device__ __forceinline__ void phase_shortconv(const P& p, int layer, int vb, int nvb) {
    const bf16_t* cb = (const bf16_t*)(p.ws + OFF_SCC); const bf16_t* hb = (const bf16_t*)(p.ws + OFF_SCH); const bf16_t* gb = (const bf16_t*)(p.ws + OFF_SCG); bf16_t* bb = (bf16_t*)(p.ws + OFF_SCB);
    const float* cw = p.sc_w + (size_t)layer * 3 * 512;
    for (int idx = vb * 512 + tidx(); idx < (T_ / 8) * 64; idx += nvb * 512) {
        const int cgp = idx & 63, run = idx >> 6, ch = cgp * 8; const size_t t0 = (size_t)run * 8; const int lseq = (int)(t0 & (SEQ_ - 1));
        f32x4 w0[3], w1[3];
#pragma unroll
        for (int k = 0; k < 3; ++k) { w0[k] = *(const f32x4*)(cw + k * 512 + ch); w1[k] = *(const f32x4*)(cw + k * 512 + ch + 4); }
        f32x4 pa0[2], pa1[2];
#pragma unroll
        for (int j = 0; j < 2; ++j) { const bool ok = lseq - 2 + j >= 0; const size_t o = (ok ? t0 - 2 + j : t0) * 512 + ch;
            u32x4 wc_ = *(const u32x4*)(cb + o), wh_ = *(const u32x4*)(hb + o); if (!ok) { wc_ = (u32x4){0u, 0u, 0u, 0u}; wh_ = wc_; }
            f32x4 c0, c1, h0, h1; unpack8(wc_, c0, c1); unpack8(wh_, h0, h1); pa0[j] = c0 * h0; pa1[j] = c1 * h1; }
#pragma unroll
        for (int hbt = 0; hbt < 2; ++hbt) {
            u32x4 rc[4], rh[4], rb[4], rg[4];
#pragma unroll
            for (int i = 0; i < 4; ++i) { const size_t o = (t0 + hbt * 4 + i) * 512 + ch; rc[i] = *(const u32x4*)(cb + o); rh[i] = *(const u32x4*)(hb + o); rb[i] = *(const u32x4*)(bb + o); rg[i] = *(const u32x4*)(gb + o); }
#pragma unroll
            for (int i = 0; i < 4; ++i) { const size_t o = (t0 + hbt * 4 + i) * 512 + ch;
                f32x4 c0, c1, h0, h1, b0, b1, g0, g1; unpack8(rc[i], c0, c1); unpack8(rh[i], h0, h1); unpack8(rb[i], b0, b1); unpack8(rg[i], g0, g1);
                const f32x4 q0 = c0 * h0, q1 = c1 * h1;
                f32x4 y0 = b0 * (w0[0] * pa0[0] + w0[1] * pa0[1] + w0[2] * q0), y1 = b1 * (w1[0] * pa1[0] + w1[1] * pa1[1] + w1[2] * q1);
#pragma unroll
                for (int j = 0; j < 4; ++j) { y0[j] *= siluf_(g0[j]); y1[j] *= siluf_(g1[j]); }
                *(u32x4*)(bb + o) = pack8(y0, y1);
                pa0[0] = pa0[1]; pa0[1] = q0; pa1[0] = pa1[1]; pa1[1] = q1; }
        }
    }
}

#define XB_TMO      128
#define XB_XCNT(j)  (256  + 64 * (j))
#define XB_XSUB(j)  (1280 + 64 * (j))
#define XB_XGEN(j)  (2304 + 64 * (j))
#define XB_TOP      3328
#define XB_TOPGEN   3392
#define XCD_BAR_WORDS 3456
#define XB_SPIN_CAP (1u << 20)
__device__ __forceinline__ unsigned xb_ld(unsigned* p)              { return __hip_atomic_load(p, __ATOMIC_RELAXED, __HIP_MEMORY_SCOPE_AGENT); }
__device__ __forceinline__ unsigned xb_add(unsigned* p, unsigned v) { return __hip_atomic_fetch_add(p, v, __ATOMIC_RELAXED, __HIP_MEMORY_SCOPE_AGENT); }
__device__ __forceinline__ unsigned xb_xcc_id() { return (unsigned)__builtin_amdgcn_s_getreg((3 << 11) | 20) & 0xFu; }
#define XB_SPIN(cond, bar) do { unsigned _sp = 0; while (cond) { __builtin_amdgcn_s_sleep(1); \
    if ((++_sp & 255u) == 0u) { if (xb_ld(&(bar)[XB_TMO])) break; if (_sp > XB_SPIN_CAP) { atomicAdd(&(bar)[XB_TMO], 1u); break; } } } } while (0)
struct XcdBarrier { unsigned* bar; unsigned x; volatile LAS unsigned* st; };
__device__ __forceinline__ XcdBarrier xcd_barrier_post(unsigned* bar, volatile LAS unsigned* st) {
    XcdBarrier b; b.bar = bar; b.x = xb_xcc_id(); b.st = st;
    if (__builtin_amdgcn_workitem_id_x() == 0) (void)xb_add(&bar[XB_XCNT(b.x)], 1u);
    return b;
}
__device__ __forceinline__ void xcd_barrier_complete(unsigned* bar, unsigned x, unsigned& nloc, unsigned& nx) {
    const unsigned G = (unsigned)gdim();
    unsigned sum, cnt, mine, sp = 0u;
    for (;;) {
        sum = 0u; cnt = 0u; mine = 0u;
        unsigned cv[16];
#pragma unroll
        for (unsigned j = 0; j < 16; ++j) cv[j] = xb_ld(&bar[XB_XCNT(j)]);
#pragma unroll
        for (unsigned j = 0; j < 16; ++j) { const unsigned c = cv[j]; sum += c; cnt += (c > 0u) ? 1u : 0u; mine = (j == x) ? c : mine; }
        if (sum == G) break;
        __builtin_amdgcn_s_sleep(1);
        if ((++sp & 255u) == 0u) { if (xb_ld(&bar[XB_TMO])) break; if (sp > XB_SPIN_CAP) { atomicAdd(&bar[XB_TMO], 1u); break; } }
    }
    nloc = mine > 0u ? mine : 1u; nx = cnt > 0u ? cnt : 1u;
}
__device__ __forceinline__ void xcd_barrier(const XcdBarrier& b) {
    asm volatile("s_waitcnt vmcnt(0)" ::: "memory");
    __syncthreads();
    if (__builtin_amdgcn_workitem_id_x() == 0) {
        unsigned* bar = b.bar;
        __builtin_amdgcn_s_waitcnt(0);
        unsigned nloc = b.st[0], nx = b.st[1];
        if (nloc == 0u) { xcd_barrier_complete(bar, b.x, nloc, nx); b.st[0] = nloc; b.st[1] = nx; }
        const unsigned old = xb_add(&bar[XB_XSUB(b.x)], 1u);
        const unsigned gen = old / nloc;
        if (old + 1u == (gen + 1u) * nloc) {
            __builtin_amdgcn_fence(__ATOMIC_RELEASE, "agent");
            asm volatile("s_waitcnt vmcnt(0)" ::: "memory");
            const unsigned og = xb_add(&bar[XB_TOP], 1u);
            const unsigned tg = og / nx;
            if (og + 1u == (tg + 1u) * nx) xb_add(&bar[XB_TOPGEN], 1u);
            else XB_SPIN(xb_ld(&bar[XB_TOPGEN]) == tg, bar);
            __builtin_amdgcn_fence(__ATOMIC_ACQUIRE, "agent");
            xb_add(&bar[XB_XGEN(b.x)], 1u);
            asm volatile("s_waitcnt vmcnt(0)" ::: "memory");
        } else {
            XB_SPIN(xb_ld(&bar[XB_XGEN(b.x)]) == gen, bar);
            __builtin_amdgcn_fence(__ATOMIC_ACQUIRE, "agent");
            asm volatile("s_waitcnt vmcnt(0)" ::: "memory");
        }
    }
    __syncthreads();
}


template <int PH> __device__ __forceinline__ void run_phase(const P& p, int layer, char* smem) {
    LAS unsigned char* lds = (LAS unsigned char*)smem;
    const int G = gdim(), c = bidx();
    const float* xin = layer == 0 ? p.x : p.out;
    if (PH == 0) { phase_prep_weights(p, layer, smem); phase_s5_tables(p, layer, smem); phase_rmsnorm_h(p, layer, xin, smem); }
    if (PH == 1) { SchedG1 S{p.ws + OFF_H, p.ws + OFF_WINT, G, c}; EpiG1 E{p.ws}; gemm_phase(lds, S, E); }
    if (PH == 2) {
        for (int L = c; L < 128; L += G) {
            { SchedS1 S{p.ws, 128, L}; EpiS1 E{}; gemm_phase(lds, S, E); }
            s5_carry_unit(p, smem, L >> 2, L & 3);
            { SchedS2 S{p.ws, 128, L}; EpiS2 E{p.ws, p.s5_d + layer * 512}; gemm_phase(lds, S, E); }
        }
        const bool split = G > 128; const int vb = split ? c - 128 : c, nvb = split ? G - 128 : G;
        phase_sgu(p, layer, smem, split ? (vb >= 0 ? vb : 128) : c, nvb);
        phase_m2_local(p, layer, smem);
        { const int vs = split ? (c < 128 ? c : -1) : c, nvs = split ? 128 : G; if (vs >= 0) phase_shortconv(p, layer, vs, nvs); } }
    if (PH == 3) {
        { SchedGLU S{p.ws, G, c}; EpiGLU E{p.ws}; gemm_phase(lds, S, E); }
        { const bool split = G > 128; const int vb = split ? c - 128 : c, nvb = split ? G - 128 : G; if (vb >= 0) phase_m2_carry(p, vb, nvb); } }
    if (PH == 4) { phase_m2_out(p, layer, smem); }
    if (PH == 6) { SchedP3 S{p.ws, G, c}; EpiP3 E{p.ws, p.merge_b + layer * 4096}; gemm_phase(lds, S, E); }
    if (PH == 7) { SchedP4 S{p.ws, G, c}; EpiP4 E{xin, p.out}; gemm_phase(lds, S, E); }
    if (PH == 8) { phase_final_norm(p); }
}

template <int PH> __global__ void __launch_bounds__(512, 2) k_phase(P p, int layer) {
    extern __shared__ __attribute__((aligned(16))) char smem[];
    run_phase<PH>(p, layer, smem);
}

#if MEGA
__global__ void __launch_bounds__(512, 2) k_mega(P p) {
    extern __shared__ __attribute__((aligned(16))) char smem[];
    cg::grid_group grid = cg::this_grid();
    if (p.ws == nullptr) grid.sync();
    volatile LAS unsigned* xbw = (volatile LAS unsigned*)(LAS unsigned char*)(smem + SMEM_BYTES - 16);
    if (__builtin_amdgcn_workitem_id_x() == 0) { xbw[0] = 0u; xbw[1] = 0u;
        const unsigned xcc = xb_xcc_id(), rank = xb_add((unsigned*)(p.ws + OFF_BAR) + 4 * xcc, 1u);
        xbw[2] = (unsigned)__builtin_amdgcn_workgroup_id_x();
        xbw[3] = rank * 8u + xcc; }
    __syncthreads();
    const XcdBarrier xb = xcd_barrier_post((unsigned*)(p.ws + OFF_BAR), xbw);
    for (int step = 0; step < 15; ++step) {
        P q = p;
        asm volatile("" : "+s"(q.ws), "+s"(q.out), "+s"(q.x));
        int layer = __builtin_amdgcn_readfirstlane(step / 7); const int ph = step - 7 * layer;
        asm volatile("" : "+s"(layer));
        if (step == 14) { run_phase<8>(q, 0, smem); break; }
        switch (ph) {
            case 0: run_phase<0>(q, layer, smem); break;
            case 1: run_phase<1>(q, layer, smem); break;
            case 2: run_phase<2>(q, layer, smem); break;
            case 3: run_phase<3>(q, layer, smem); break;
            case 4: run_phase<4>(q, layer, smem); break;
            case 5: run_phase<6>(q, layer, smem); break;
            default: run_phase<7>(q, layer, smem); break;
        }
        xcd_barrier(xb);
        if (step == 0) {
            if (__builtin_amdgcn_workitem_id_x() == 0) { bool ok = gdim() == 256;
                unsigned cv[16];
#pragma unroll
                for (unsigned j = 0; j < 16; ++j) cv[j] = xb_ld((unsigned*)(p.ws + OFF_BAR) + XB_XCNT(j));
#pragma unroll
                for (unsigned j = 0; j < 16; ++j) ok = ok && (cv[j] == (j < 8u ? 32u : 0u));
                if (ok) xbw[2] = xbw[3]; }
            __syncthreads();
        }
    }
}
#endif

template <int PH> static void launch_phase(const P& p, int layer, hipStream_t stream) {
    static bool attr = false;
    if (!attr) { hipFuncSetAttribute((const void*)k_phase<PH>, hipFuncAttributeMaxDynamicSharedMemorySize, SMEM_BYTES); attr = true; }
    hipLaunchKernelGGL(k_phase<PH>, dim3(256), dim3(512), SMEM_BYTES, stream, p, layer);
}

extern "C" void kernel_launch(void* const* d_in, const int* in_sizes, int n_in, void* d_out, int out_size, void* d_ws, size_t ws_size, hipStream_t stream) {
    if (ws_size < WS_NEED) { fprintf(stderr, "workspace too small: %zu < %zu\n", ws_size, (size_t)WS_NEED); return; }
    P p{};
    const float** f = (const float**)&p;
    for (int i = 0; i < 27; ++i) f[i] = (const float*)d_in[i];
    p.out = (float*)d_out; p.ws = (char*)d_ws;
#if MEGA
    static int grid_blocks = 0;
    if (!grid_blocks) {
        hipFuncSetAttribute((const void*)k_mega, hipFuncAttributeMaxDynamicSharedMemorySize, SMEM_BYTES);
        int dev = 0, cus = 0, per_cu = 0; hipGetDevice(&dev); hipDeviceGetAttribute(&cus, hipDeviceAttributeMultiprocessorCount, dev);
        hipOccupancyMaxActiveBlocksPerMultiprocessor(&per_cu, k_mega, 512, SMEM_BYTES);
        if (per_cu > 1) per_cu = 1;
        grid_blocks = cus * per_cu;
    }
    (void)hipMemsetAsync((char*)d_ws + OFF_BAR, 0, XCD_BAR_WORDS * 4, stream);
    void* args[] = {&p};
    hipError_t e = hipLaunchCooperativeKernel((const void*)k_mega, dim3(grid_blocks), dim3(512), args, SMEM_BYTES, stream);
    if (e != hipSuccess) fprintf(stderr, "cooperative launch failed: %s (grid %d)\n", hipGetErrorString(e), grid_blocks);
#else
    for (int layer = 0; layer < 2; ++layer) {
#define LP(ph) do { launch_phase<ph>(p, layer, stream); if (PROBE_PH == ph) { launch_phase<ph>(p, layer, stream); launch_phase<ph>(p, layer, stream); } } while (0)
        LP(0); LP(1); LP(2); LP(3); LP(4); LP(6); LP(7);
    }
    launch_phase<8>(p, 0, stream);
#endif
}
```

```cpp
#include <hip/hip_runtime.h>
#include <hip/hip_cooperative_groups.h>
#include <cstdio>
namespace cg = cooperative_groups;

#ifndef MEGA
#define MEGA 1
#endif
#ifndef PROBE_PH
#define PROBE_PH -1
#endif
#ifndef PROBE_SUB
#define PROBE_SUB 0
#endif

#define LAS __attribute__((address_space(3)))
typedef unsigned short bf16_t;
typedef short bf16x8 __attribute__((ext_vector_type(8)));
typedef float f32x4 __attribute__((ext_vector_type(4)));
typedef float f32x2 __attribute__((ext_vector_type(2)));
typedef unsigned u32x4 __attribute__((ext_vector_type(4)));
typedef unsigned u32x2 __attribute__((ext_vector_type(2)));

constexpr int SMEM_BYTES = 150528;
#define VBID_LDS_OFF (SMEM_BYTES - 8)
constexpr int T_ = 16384, D_ = 1024, W_ = 512, SEQ_ = 2048;
constexpr int IN_DIM_ = 10248;
constexpr size_t MiB = 1048576;
constexpr size_t OFF_WINT = 0, OFF_WBT = 20 * MiB, OFF_WOUTT = 24 * MiB, OFF_WGLUT = 26 * MiB, OFF_DTRAW = 26 * MiB + MiB / 2,
                 OFF_H = 27 * MiB, OFF_A2 = 59 * MiB, OFF_S5G = 83 * MiB, OFF_SGUU = 99 * MiB, OFF_M2Z = 115 * MiB, OFF_SCB = 131 * MiB,
                 OFF_SGUV = 147 * MiB, OFF_SGUG = 163 * MiB, OFF_XBC = 179 * MiB, OFF_SCC = 211 * MiB, OFF_SCH = 227 * MiB, OFF_SCG = 243 * MiB,
                 OFF_B2TAB = 259 * MiB, OFF_GTAB = 265 * MiB, OFF_YS5 = 267 * MiB + MiB / 4, OFF_M2ST = 283 * MiB + MiB / 4,
                 OFF_YPART = 299 * MiB + MiB / 4, OFF_EACS = 315 * MiB + MiB / 4, OFF_ACH = 315 * MiB + 3 * MiB / 4, OFF_AQ = 315 * MiB + 7 * MiB / 8,
                 OFF_BAR = 316 * MiB, WS_NEED = 316 * MiB + 16384;
constexpr size_t OFF_CCONV = 0;
constexpr size_t OFF_MERGED = OFF_XBC, OFF_GS = OFF_SCC, OFF_PART = OFF_SCG;

struct P {
    const float *x, *norm_w, *w_in, *lam_re, *lam_im, *b_re, *b_im, *c_re, *c_im, *s5_d, *log_step, *w_glu, *ln_w, *ln_b, *sgu_w, *sgu_b,
        *conv_w, *conv_b, *dt_bias, *a_log, *m2_d, *m2_norm_w, *sc_w, *merge_b, *w_branch, *w_out, *final_w;
    float* out;
    char* ws;
};

typedef __bf16 bf16v2 __attribute__((ext_vector_type(2)));
__device__ __forceinline__ unsigned cvt_pk_bf16(float lo, float hi) { const f32x2 v = {lo, hi}; const bf16v2 b = __builtin_convertvector(v, bf16v2); return __builtin_bit_cast(unsigned, b); }
__device__ __forceinline__ int tidx() { int t = __builtin_amdgcn_workitem_id_x(); asm volatile("" : "+v"(t)); return t; }
#if MEGA
__device__ __forceinline__ int bidx() { int t = (int)*(volatile LAS unsigned*)(VBID_LDS_OFF); t = __builtin_amdgcn_readfirstlane(t); asm volatile("" : "+s"(t)); return t; }
#else
__device__ __forceinline__ int bidx() { int t = __builtin_amdgcn_workgroup_id_x(); asm volatile("" : "+s"(t)); return t; }
#endif
__device__ __forceinline__ int gdim() { int t = (int)__builtin_amdgcn_grid_size_x() / (int)__builtin_amdgcn_workgroup_size_x(); asm volatile("" : "+s"(t)); return t; }
__device__ __forceinline__ bf16_t f2bf(float f) { return (bf16_t)(cvt_pk_bf16(f, 0.f) & 0xffffu); }
__device__ __forceinline__ float bf2f(unsigned b) { return __uint_as_float(b << 16); }
__device__ __forceinline__ float bflo(unsigned w) { return __uint_as_float(w << 16); }
__device__ __forceinline__ float bfhi(unsigned w) { return __uint_as_float(w & 0xffff0000u); }
__device__ __forceinline__ float sigmoidf_(float z) { return __builtin_amdgcn_rcpf(1.0f + __expf(-z)); }
__device__ __forceinline__ float siluf_(float z) { return z * sigmoidf_(z); }
__device__ __forceinline__ float sig2f_(float a, float b) { return __builtin_amdgcn_rcpf((1.0f + __expf(-a)) * (1.0f + __expf(-b))); }
__device__ __forceinline__ float geluarg_(float v) { return 1.5957691216f * (v + 0.044715f * v * v * v); }
__device__ __forceinline__ float geluf_(float v) { const float z = 1.5957691216f * (v + 0.044715f * v * v * v); return v * sigmoidf_(z); }
__device__ __forceinline__ u32x4 pack8(const f32x4 a, const f32x4 b) { u32x4 r; r[0] = cvt_pk_bf16(a[0], a[1]); r[1] = cvt_pk_bf16(a[2], a[3]); r[2] = cvt_pk_bf16(b[0], b[1]); r[3] = cvt_pk_bf16(b[2], b[3]); return r; }
__device__ __forceinline__ void unpack8(const u32x4 r, f32x4& a, f32x4& b) { a[0] = bflo(r[0]); a[1] = bfhi(r[0]); a[2] = bflo(r[1]); a[3] = bfhi(r[1]); b[0] = bflo(r[2]); b[1] = bfhi(r[2]); b[2] = bflo(r[3]); b[3] = bfhi(r[3]); }

constexpr int BM = 256, BK = 64, HALF = 128, HTB = HALF * BK * 2, STAGE_BYTES = 8 * HTB;
__device__ __forceinline__ int lds_byte(int r, int c) { const int st = (r >> 4) * 2 + (c >> 5), rr = r & 15, cc = c & 31, ob = rr * 64 + cc * 2; return st * 1024 + (ob ^ (((ob >> 9) & 1) << 5)); }
__device__ __forceinline__ void stage_rc(int b, int& R, int& C) { const int st = b / 1024, sb = b % 1024, swz = sb ^ (((sb >> 9) & 1) << 5); R = (st >> 1) * 16 + swz / 64; C = (st & 1) * 32 + (swz % 64) / 2; }
__device__ __forceinline__ int perm32(int rho) { const int n = rho >> 4, i = rho & 15; return 8 * (i >> 2) + 4 * n + (i & 3); }

struct Unit { const char* A; const char* B; unsigned lda2, ldb2; int nt, tag, pm, pn; };

template <class Epi, class Sched>
__device__ __forceinline__ void gemm_phase(LAS unsigned char* lds, const Sched& S, const Epi& E) {
    const int tid = tidx(), wid = __builtin_amdgcn_readfirstlane(tid >> 6), lane = tid & 63, wr = wid >> 2, wc = wid & 3, fr = lane & 15, fq = lane >> 4;
    unsigned pkR = 0u, pkC = 0u;
#pragma unroll
    for (int i = 0; i < 2; ++i) { int R, C; stage_rc(tid * 16 + i * 8192, R, C); pkR |= ((unsigned)R << (8 * i)) | ((unsigned)((R & ~31) + perm32(R & 31)) << (16 + 8 * i)); pkC |= ((unsigned)C * 2u) << (8 * i); }
#define RA 0
#define RB 16
    const size_t kstep = (size_t)(BK * 2);
    const unsigned ldsw = (unsigned)wid * 1024u;
    const int aoff = lds_byte(wr * 64 + fr, fq * 8), boff = lds_byte(wc * 32 + fr, fq * 8);
#define G_SA(b, h) (((b) * 2 + (h)) * HTB)
#define G_SB(b, h) ((4 + (b) * 2 + (h)) * HTB)
#define G_STAGE(bufoff, gbase, ld2, hf, RV) do { _Pragma("unroll") for (int _i = 0; _i < 2; ++_i) \
        __builtin_amdgcn_global_load_lds((const unsigned*)((const char*)(gbase) + (size_t)(((unsigned)(hf) * HALF + ((pkR >> (RV + 8 * _i)) & 0xffu)) * (ld2) + ((pkC >> (8 * _i)) & 0xffu))), (LAS unsigned*)(lds + (bufoff) + ldsw + _i * 8192), 16, 0, 0); } while (0)
#define G_LDA(dst, b, h) do { _Pragma("unroll") for (int m = 0; m < 4; ++m) _Pragma("unroll") for (int k = 0; k < 2; ++k) dst[m][k] = *(const LAS bf16x8*)(lds + G_SA(b, h) + aoff + m * 2048 + k * 1024); } while (0)
#define G_LDB(dst, b, h) do { _Pragma("unroll") for (int n = 0; n < 2; ++n) _Pragma("unroll") for (int k = 0; k < 2; ++k) dst[n][k] = *(const LAS bf16x8*)(lds + G_SB(b, h) + boff + n * 2048 + k * 1024); } while (0)
#define G_MMA(ai, bj, At, Bt) do { __builtin_amdgcn_s_setprio(1); _Pragma("unroll") for (int m = 0; m < 4; ++m) _Pragma("unroll") for (int n = 0; n < 2; ++n) _Pragma("unroll") for (int k = 0; k < 2; ++k) \
        acc[ai][bj][m][n] = __builtin_amdgcn_mfma_f32_16x16x32_bf16(Bt[n][k], At[m][k], acc[ai][bj][m][n], 0, 0, 0); __builtin_amdgcn_s_setprio(0); } while (0)
#define G_WAIT_V(n) asm volatile("s_waitcnt vmcnt(" #n ")" ::: "memory")
#define G_WAIT_L(n) asm volatile("s_waitcnt lgkmcnt(" #n ")" ::: "memory")
#define G_BAR __builtin_amdgcn_s_barrier()
#define G_SCHED __builtin_amdgcn_sched_barrier(0)
    Unit cur, nxt; int ui = 0;
    if (!S.next(0, cur)) return;
    f32x4 acc[2][2][4][2];
#pragma unroll
    for (int a = 0; a < 2; ++a)
#pragma unroll
        for (int b = 0; b < 2; ++b)
#pragma unroll
            for (int m = 0; m < 4; ++m)
#pragma unroll
                for (int n = 0; n < 2; ++n) acc[a][b][m][n] = (f32x4){0.f, 0.f, 0.f, 0.f};
    bf16x8 At[4][2], B0[2][2], B1[2][2];
    const char* cA = cur.A; const char* cB = cur.B; unsigned cla = cur.lda2, clb = cur.ldb2;
    G_STAGE(G_SB(0, 0), cB, clb, 0, RB); G_STAGE(G_SA(0, 0), cA, cla, 0, RA); G_STAGE(G_SB(0, 1), cB, clb, 1, RB); G_STAGE(G_SA(0, 1), cA, cla, 1, RA);
    if (wr == 1) G_BAR;
    G_WAIT_V(4); G_BAR;
    G_STAGE(G_SB(1, 0), cB + kstep, clb, 0, RB); G_STAGE(G_SA(1, 0), cA + kstep, cla, 0, RA); G_STAGE(G_SB(1, 1), cB + kstep, clb, 1, RB);
    G_WAIT_V(6); G_BAR;
    for (;;) {
        const bool has_next = S.next(ui + 1, nxt);
        const char* nA = has_next ? nxt.A : cA; const char* nB = has_next ? nxt.B : cB;
        const unsigned nla = has_next ? nxt.lda2 : cla, nlb = has_next ? nxt.ldb2 : clb;
        const int nt = cur.nt;
        for (int t = 0; t < nt; t += 2) {
            const bool last = (t == nt - 2);
            const char* a1 = cA + (size_t)(t + 1) * kstep;
            const char* a2 = last ? nA : cA + (size_t)(t + 2) * kstep; const char* b2 = last ? nB : cB + (size_t)(t + 2) * kstep;
            const unsigned la2 = last ? nla : cla, lb2 = last ? nlb : clb;
            const char* a3 = a2 + kstep; const char* b3 = b2 + kstep;
            G_LDB(B0, 0, 0); G_SCHED; G_LDA(At, 0, 0); G_STAGE(G_SA(1, 1), a1, cla, 1, RA);
            G_WAIT_L(8); G_BAR; G_WAIT_L(0); G_MMA(0, 0, At, B0); G_BAR; G_SCHED;
            G_LDB(B1, 0, 1); G_STAGE(G_SB(0, 0), b2, lb2, 0, RB);
            G_BAR; G_WAIT_L(0); G_MMA(0, 1, At, B1); G_BAR;
            G_LDA(At, 0, 1); G_STAGE(G_SA(0, 0), a2, la2, 0, RA);
            G_BAR; G_WAIT_L(0); G_MMA(1, 0, At, B0); G_BAR; G_SCHED;
            G_STAGE(G_SB(0, 1), b2, lb2, 1, RB);
            G_WAIT_V(6); G_BAR; G_MMA(1, 1, At, B1); G_BAR;
            G_LDB(B0, 1, 0); G_SCHED; G_LDA(At, 1, 0); G_STAGE(G_SA(0, 1), a2, la2, 1, RA);
            G_WAIT_L(8); G_BAR; G_WAIT_L(0); G_MMA(0, 0, At, B0); G_BAR; G_SCHED;
            G_LDB(B1, 1, 1); G_STAGE(G_SB(1, 0), b3, lb2, 0, RB);
            G_BAR; G_WAIT_L(0); G_MMA(0, 1, At, B1); G_BAR;
            G_LDA(At, 1, 1); G_STAGE(G_SA(1, 0), a3, la2, 0, RA);
            G_BAR; G_WAIT_L(0); G_MMA(1, 0, At, B0); G_BAR; G_SCHED;
            G_STAGE(G_SB(1, 1), b3, lb2, 1, RB);
            G_WAIT_V(6); G_BAR; G_MMA(1, 1, At, B1); G_BAR;
        }
        if constexpr (!Epi::AFTER_DRAIN) E(acc, cur, wr, wc, fr, fq);
        if (!has_next) break;
#pragma unroll
        for (int a = 0; a < 2; ++a)
#pragma unroll
            for (int b = 0; b < 2; ++b)
#pragma unroll
                for (int m = 0; m < 4; ++m)
#pragma unroll
                    for (int n = 0; n < 2; ++n) acc[a][b][m][n] = (f32x4){0.f, 0.f, 0.f, 0.f};
        cur = nxt; cA = nA; cB = nB; cla = nla; clb = nlb; ++ui;
    }
    G_WAIT_V(0);
    if (wr == 0) G_BAR;
    G_BAR;
    if constexpr (Epi::AFTER_DRAIN) E.drained(acc, cur, wr, wc, fr, fq, lds);
#undef RA
#undef RB
#undef G_SA
#undef G_SB
#undef G_STAGE
#undef G_LDA
#undef G_LDB
#undef G_MMA
#undef G_WAIT_V
#undef G_WAIT_L
#undef G_BAR
#undef G_SCHED
}

__device__ __forceinline__ bool tile_order(long L, int nM, int nN, int& pm, int& pn) {
    const int nwg = nM * nN; if (L >= nwg) return false;
    int wgid = (int)L; { const int q = nwg / 8, r = nwg % 8, xcd = wgid % 8, off = wgid / 8; wgid = (xcd < r ? xcd * (q + 1) : r * (q + 1) + (xcd - r) * q) + off; }
    const int nig = 8 * nN, gid = wgid / nig, fm = gid * 8, gsz = (nM - fm) < 8 ? (nM - fm) : 8;
    pm = fm + ((wgid % nig) % gsz); pn = (wgid % nig) / gsz; return true;
}

struct SchedG1 { const char* A; const char* B; int G, c;
    __device__ __forceinline__ bool next(int i, Unit& u) const { int pm, pn; if (!tile_order((long)i * G + c, 64, 24, pm, pn)) return false;
        u.A = A + (size_t)pm * 256 * 2048; u.B = B + (size_t)pn * 256 * 2048; u.lda2 = 2048; u.ldb2 = 2048; u.nt = 16; u.tag = 0; u.pm = pm; u.pn = pn; return true; } };
struct EpiG1 { static constexpr bool AFTER_DRAIN = false; char* ws;
    __device__ __forceinline__ void operator()(const f32x4 (&acc)[2][2][4][2], const Unit& u, int wr, int wc, int fr, int fq) const {
        const int seg = u.pn >> 1, cb = (u.pn & 1) * 256 + wc * 32 + 8 * fq;
        bf16_t* base; int ld = 512, coff = 0;
        switch (seg) {
            case 1: base = (bf16_t*)(ws + OFF_S5G); break; case 2: base = (bf16_t*)(ws + OFF_SGUU); break; case 3: base = (bf16_t*)(ws + OFF_SGUV); break;
            case 4: base = (bf16_t*)(ws + OFF_SGUG); break; case 5: base = (bf16_t*)(ws + OFF_M2Z); break;
            case 6: base = (bf16_t*)(ws + OFF_XBC); ld = 1024; break; case 7: base = (bf16_t*)(ws + OFF_XBC); ld = 1024; coff = 512; break;
            case 8: base = (bf16_t*)(ws + OFF_SCB); break; case 9: base = (bf16_t*)(ws + OFF_SCC); break; case 10: base = (bf16_t*)(ws + OFF_SCH); break;
            case 11: base = (bf16_t*)(ws + OFF_SCG); break; default: base = (bf16_t*)(ws + OFF_A2); break;
        }
#pragma unroll
        for (int ai = 0; ai < 2; ++ai)
#pragma unroll
            for (int m = 0; m < 4; ++m) {
                const int row = u.pm * 256 + ai * 128 + wr * 64 + m * 16 + fr;
#pragma unroll
                for (int bj = 0; bj < 2; ++bj) {
                    const int col = cb + bj * 128;
                    const u32x4 v = pack8(acc[ai][bj][m][0], acc[ai][bj][m][1]);
                    bf16_t* dst;
                    if (seg == 0) dst = base + ((size_t)((col >> 4) * 1024 + (row >> 4)) * 384 + 128 + (row & 15) * 16 + (col & 15));
                    else dst = base + (size_t)row * ld + coff + col;
                    *(u32x4*)dst = v;
                }
            }
    } };

struct SchedS1 { char* ws; int G, c;
    __device__ __forceinline__ bool next(int i, Unit& u) const { const long L = (long)i * G + c; if (L >= 128) return false; const int g = (int)L >> 2, pm = (int)L & 3;
        u.A = ws + OFF_A2 + ((size_t)(g * 1024 + pm * 256) * 384 + 128) * 2; u.B = ws + OFF_GTAB + (size_t)g * 128 * 256 * 2; u.lda2 = 768; u.ldb2 = 512; u.nt = 4; u.tag = g; u.pm = pm; u.pn = 0; return true; } };
struct EpiS1 { static constexpr bool AFTER_DRAIN = true;
    __device__ __forceinline__ void drained(const f32x4 (&acc)[2][2][4][2], const Unit& u, int wr, int wc, int fr, int fq, LAS unsigned char* lds) const {
#pragma unroll
        for (int ai = 0; ai < 2; ++ai)
#pragma unroll
            for (int m = 0; m < 4; ++m) { const int row = ai * 128 + wr * 64 + m * 16 + fr;
                *(LAS u32x4*)(lds + (row * 128 + wc * 32 + 8 * fq) * 2) = pack8(acc[ai][0][m][0], acc[ai][0][m][1]); }
    } };
struct SchedS2 { char* ws; int G, c;
    __device__ __forceinline__ bool next(int i, Unit& u) const { const long L = (long)i * G + c; if (L >= 128) return false; const int g = (int)L >> 2, pm = (int)L & 3;
        u.A = ws + OFF_A2 + (size_t)(g * 1024 + pm * 256) * 768; u.B = ws + OFF_B2TAB + (size_t)g * 256 * 768; u.lda2 = 768; u.ldb2 = 768; u.nt = 6; u.tag = g; u.pm = pm; u.pn = 0; return true; } };
struct EpiS2 { static constexpr bool AFTER_DRAIN = false; char* ws; const float* dvec;
    __device__ __forceinline__ void operator()(const f32x4 (&acc)[2][2][4][2], const Unit& u, int, int, int, int) const {
        const int tq = tidx(), wr = tq >> 8, wc = (tq >> 6) & 3, fr = tq & 15, fq = (tq >> 4) & 3;
        const int g = u.tag;
        const bf16_t* a2 = (const bf16_t*)(ws + OFF_A2) + (size_t)g * 1024 * 384;
        bf16_t* ys = (bf16_t*)(ws + OFF_YS5);
#pragma unroll
        for (int bj = 0; bj < 2; ++bj) {
            const int col = bj * 128 + wc * 32 + 8 * fq, t = col >> 4, p0 = col & 15;
            const f32x4 d0 = *(const f32x4*)(dvec + g * 16 + p0), d1 = *(const f32x4*)(dvec + g * 16 + p0 + 4);
            u32x4 uu[2][4];
#pragma unroll
            for (int ai = 0; ai < 2; ++ai)
#pragma unroll
                for (int m = 0; m < 4; ++m) uu[ai][m] = *(const u32x4*)(a2 + (size_t)(u.pm * 256 + ai * 128 + wr * 64 + m * 16 + fr) * 384 + 128 + col);
#pragma unroll
            for (int ai = 0; ai < 2; ++ai)
#pragma unroll
                for (int m = 0; m < 4; ++m) { const int row = u.pm * 256 + ai * 128 + wr * 64 + m * 16 + fr;
                    f32x4 u0, u1; unpack8(uu[ai][m], u0, u1);
                    f32x4 y0 = acc[ai][bj][m][0] + d0 * u0, y1 = acc[ai][bj][m][1] + d1 * u1;
#pragma unroll
                    for (int j = 0; j < 4; ++j) { y0[j] = geluf_(y0[j]); y1[j] = geluf_(y1[j]); }
                    *(u32x4*)(ys + (size_t)(row * 16 + t) * 512 + g * 16 + p0) = pack8(y0, y1); }
            __builtin_amdgcn_sched_barrier(0);
        }
    } };
struct SchedGLU { char* ws; int G, c;
    __device__ __forceinline__ bool next(int i, Unit& u) const { const long L = (long)i * G + c; if (L >= 128) return false; const int pm = (int)L >> 1, pn = (int)L & 1;
        u.A = ws + OFF_YS5 + (size_t)pm * 256 * 1024; u.B = ws + OFF_WGLUT + (size_t)pn * 256 * 1024; u.lda2 = 1024; u.ldb2 = 1024; u.nt = 8; u.tag = 0; u.pm = pm; u.pn = pn; return true; } };
struct EpiGLU { static constexpr bool AFTER_DRAIN = false; char* ws;
    __device__ __forceinline__ void operator()(const f32x4 (&acc)[2][2][4][2], const Unit& u, int, int, int, int) const {
        const int tq = tidx(), wr = tq >> 8, wc = (tq >> 6) & 3, fr = tq & 15, fq = (tq >> 4) & 3;
        const bf16_t* ys = (const bf16_t*)(ws + OFF_YS5); bf16_t* gt = (bf16_t*)(ws + OFF_S5G);
#pragma unroll
        for (int ai = 0; ai < 2; ++ai)
#pragma unroll
            for (int bj = 0; bj < 2; ++bj) {
                u32x4 yy[4], gg[4];
#pragma unroll
                for (int m = 0; m < 4; ++m) { const size_t o = (size_t)(u.pm * 256 + ai * 128 + wr * 64 + m * 16 + fr) * 512 + u.pn * 256 + bj * 128 + wc * 32 + 8 * fq; yy[m] = *(const u32x4*)(ys + o); gg[m] = *(const u32x4*)(gt + o); }
#pragma unroll
                for (int m = 0; m < 4; ++m) { const size_t o = (size_t)(u.pm * 256 + ai * 128 + wr * 64 + m * 16 + fr) * 512 + u.pn * 256 + bj * 128 + wc * 32 + 8 * fq;
                    f32x4 y0, y1, g0, g1; unpack8(yy[m], y0, y1); unpack8(gg[m], g0, g1);
                    f32x4 r0, r1;
#pragma unroll
                    for (int j = 0; j < 4; ++j) { r0[j] = y0[j] * g0[j] * sig2f_(acc[ai][bj][m][0][j], g0[j]); r1[j] = y1[j] * g1[j] * sig2f_(acc[ai][bj][m][1][j], g1[j]); }
                    *(u32x4*)(gt + o) = pack8(r0, r1); }
                __builtin_amdgcn_sched_barrier(0);
            }
    } };
struct SchedP3 { char* ws; int G, c;
    __device__ __forceinline__ bool next(int i, Unit& u) const { int pm, pn; if (!tile_order((long)(i >> 3) * G + c, 64, 4, pm, pn)) return false; const int sub = i & 7, k = sub >> 1;
        if (!(sub & 1)) { u.A = ws + OFF_H + (size_t)pm * 256 * 2048; u.B = ws + OFF_WINT + (size_t)(6144 + k * 1024 + pn * 256) * 2048; u.lda2 = 2048; u.ldb2 = 2048; u.nt = 16; }
        else { const size_t yo = k == 0 ? OFF_S5G : k == 1 ? OFF_SGUU : k == 2 ? OFF_M2Z : OFF_SCB;
            u.A = ws + yo + (size_t)pm * 256 * 1024; u.B = ws + OFF_WBT + (size_t)(k * 1024 + pn * 256) * 1024; u.lda2 = 1024; u.ldb2 = 1024; u.nt = 8; }
        u.tag = sub; u.pm = pm; u.pn = pn; return true; } };
template <int KC> __device__ __forceinline__ void p3_branch_epi(const f32x4 (&acc)[2][2][4][2], char* gsb, char* psb, bf16_t* mg, const Unit& u, int wr, int wc, int fr, int fq) {
#pragma unroll
    for (int ai = 0; ai < 2; ++ai)
#pragma unroll
        for (int bj = 0; bj < 2; ++bj) {
            u32x4 pk[2], pp[4];
#pragma unroll
            for (int mp = 0; mp < 2; ++mp) pk[mp] = *(const u32x4*)(gsb + ((ai * 2 + bj) * 2 + mp) * 8192);
            if (KC > 0) {
#pragma unroll
                for (int m = 0; m < 4; ++m) pp[m] = *(const u32x4*)(psb + ((ai * 2 + bj) * 4 + m) * 8192);
            }
#pragma unroll
            for (int m = 0; m < 4; ++m) { const int slot = (ai * 2 + bj) * 4 + m; const unsigned w0 = pk[m >> 1][(m & 1) * 2], w1 = pk[m >> 1][(m & 1) * 2 + 1];
                f32x4 g0, g1;
#pragma unroll
                for (int j = 0; j < 4; ++j) { g0[j] = (float)((w0 >> (8 * j)) & 0xffu); g1[j] = (float)((w1 >> (8 * j)) & 0xffu); }
                f32x4 v0, v1;
                if (KC > 0) { f32x4 p0, p1; unpack8(pp[m], p0, p1);
#pragma unroll
                    for (int j = 0; j < 4; ++j) { v0[j] = __builtin_fmaf(g0[j], acc[ai][bj][m][0][j], p0[j]); v1[j] = __builtin_fmaf(g1[j], acc[ai][bj][m][1][j], p1[j]); } }
                else { v0 = g0 * acc[ai][bj][m][0]; v1 = g1 * acc[ai][bj][m][1]; }
                if (KC < 3) *(u32x4*)(psb + slot * 8192) = pack8(v0, v1);
                else { const int row = u.pm * 256 + ai * 128 + wr * 64 + m * 16 + fr, col = u.pn * 256 + bj * 128 + wc * 32 + 8 * fq;
                    *(u32x4*)(mg + (size_t)row * 1024 + col) = pack8(v0 * (1.0f / 255.0f), v1 * (1.0f / 255.0f)); }
            }
            __builtin_amdgcn_sched_barrier(0);
        }
}
struct EpiP3 { static constexpr bool AFTER_DRAIN = false; char* ws; const float* mb;
    __device__ __forceinline__ void operator()(const f32x4 (&acc)[2][2][4][2], const Unit& u, int, int, int, int) const {
        const int k = u.tag >> 1;
        const int tq = tidx(), wr = tq >> 8, wc = (tq >> 6) & 3, fr = tq & 15, fq = (tq >> 4) & 3;
        unsigned t16 = (unsigned)tq * 16u; asm volatile("" : "+v"(t16));
        char* gsb = ws + OFF_GS + (size_t)bidx() * (8 * 512 * 16) + t16;
        char* psb = ws + OFF_PART + (size_t)bidx() * (16 * 512 * 16) + t16;
        if (!(u.tag & 1)) {
#pragma unroll
            for (int bj = 0; bj < 2; ++bj) { const int col = u.pn * 256 + bj * 128 + wc * 32 + 8 * fq;
                const f32x4 b0 = *(const f32x4*)(mb + k * 1024 + col) * -1.4426950408889634f, b1 = *(const f32x4*)(mb + k * 1024 + col + 4) * -1.4426950408889634f;
#pragma unroll
                for (int ai = 0; ai < 2; ++ai)
#pragma unroll
                    for (int mp = 0; mp < 2; ++mp) { u32x4 pk;
#pragma unroll
                        for (int mm = 0; mm < 2; ++mm) { const int m = mp * 2 + mm; unsigned w0 = 0u, w1 = 0u;
#pragma unroll
                            for (int j = 0; j < 4; ++j) {
                                const float e0 = __builtin_amdgcn_exp2f(__builtin_fmaf(acc[ai][bj][m][0][j], -1.4426950408889634f, b0[j])), e1 = __builtin_amdgcn_exp2f(__builtin_fmaf(acc[ai][bj][m][1][j], -1.4426950408889634f, b1[j]));
                                w0 = __builtin_amdgcn_cvt_pk_u8_f32(__builtin_amdgcn_rcpf(__builtin_fmaf(e0, 1.0f / 255.0f, 1.0f / 255.0f)), j, w0);
                                w1 = __builtin_amdgcn_cvt_pk_u8_f32(__builtin_amdgcn_rcpf(__builtin_fmaf(e1, 1.0f / 255.0f, 1.0f / 255.0f)), j, w1); }
                            pk[mm * 2] = w0; pk[mm * 2 + 1] = w1; }
                        *(u32x4*)(gsb + ((ai * 2 + bj) * 2 + mp) * 8192) = pk; }
            }
        } else {
            bf16_t* mg = (bf16_t*)(ws + OFF_MERGED);
            if (k == 0) p3_branch_epi<0>(acc, gsb, psb, mg, u, wr, wc, fr, fq);
            else if (k == 3) p3_branch_epi<3>(acc, gsb, psb, mg, u, wr, wc, fr, fq);
            else p3_branch_epi<1>(acc, gsb, psb, mg, u, wr, wc, fr, fq);
        }
    } };
struct SchedP4 { char* ws; int G, c;
    __device__ __forceinline__ bool next(int i, Unit& u) const { int pm, pn; if (!tile_order((long)i * G + c, 64, 4, pm, pn)) return false;
        u.A = ws + OFF_MERGED + (size_t)pm * 256 * 2048; u.B = ws + OFF_WOUTT + (size_t)pn * 256 * 2048; u.lda2 = 2048; u.ldb2 = 2048; u.nt = 16; u.tag = 0; u.pm = pm; u.pn = pn; return true; } };
struct EpiP4 { static constexpr bool AFTER_DRAIN = false; const float* xin; float* xout;
    __device__ __forceinline__ void operator()(const f32x4 (&acc)[2][2][4][2], const Unit& u, int, int, int, int) const {
        const int tq = tidx(), wr = tq >> 8, wc = (tq >> 6) & 3, fr = tq & 15, fq = (tq >> 4) & 3;
#pragma unroll
        for (int ai = 0; ai < 2; ++ai)
#pragma unroll
            for (int bj = 0; bj < 2; ++bj) {
                f32x4 xr[4][2];
#pragma unroll
                for (int m = 0; m < 4; ++m) { const size_t o = (size_t)(u.pm * 256 + ai * 128 + wr * 64 + m * 16 + fr) * 1024 + u.pn * 256 + bj * 128 + wc * 32 + 8 * fq;
                    xr[m][0] = *(const f32x4*)(xin + o); xr[m][1] = *(const f32x4*)(xin + o + 4); }
#pragma unroll
                for (int m = 0; m < 4; ++m) { const size_t o = (size_t)(u.pm * 256 + ai * 128 + wr * 64 + m * 16 + fr) * 1024 + u.pn * 256 + bj * 128 + wc * 32 + 8 * fq;
                    *(f32x4*)(xout + o) = xr[m][0] + acc[ai][bj][m][0]; *(f32x4*)(xout + o + 4) = xr[m][1] + acc[ai][bj][m][1]; }
                __builtin_amdgcn_sched_barrier(0);
            }
    } };

constexpr int LDP = 136;
__device__ __forceinline__ bf16x8 ldfrag(const bf16_t* base, int row, int k0) { return *(const bf16x8*)(base + row * LDP + k0); }
__device__ __forceinline__ int xrow(int p) { return (p & ~7) | ((p + (p >> 3)) & 7); }
__device__ __forceinline__ f32x4 mma16(bf16x8 a, bf16x8 b, f32x4 c) { return __builtin_amdgcn_mfma_f32_16x16x32_bf16(a, b, c, 0, 0, 0); }

__device__ __forceinline__ void transpose_tile(float* tile, const float* src, size_t ldn, bf16_t* dst, size_t ldk) {
    const int tid = tidx();
    {
        const int k0 = tid >> 6, n4 = (tid & 63) * 4;
        f32x4 v[8];
#pragma unroll
        for (int j = 0; j < 8; ++j) v[j] = *(const f32x4*)(src + (size_t)(k0 + j * 8) * ldn + n4);
#pragma unroll
        for (int j = 0; j < 8; ++j) { float* t = tile + (k0 + j * 8) * 257 + n4; t[0] = v[j][0]; t[1] = v[j][1]; t[2] = v[j][2]; t[3] = v[j][3]; }
    }
    __syncthreads();
    {
        const int n = tid >> 1, kb = (tid & 1) * 32;
#pragma unroll
        for (int j = 0; j < 4; ++j) { f32x4 a, b;
#pragma unroll
            for (int e = 0; e < 4; ++e) { a[e] = tile[(kb + j * 8 + e) * 257 + n]; b[e] = tile[(kb + j * 8 + 4 + e) * 257 + n]; }
            *(u32x4*)(dst + (size_t)n * ldk + kb + j * 8) = pack8(a, b); }
    }
    __syncthreads();
}

__device__ void phase_prep_weights(const P& p, int layer, char* smem) {
    float* tile = (float*)smem;
    const float* w_in = p.w_in + (size_t)layer * 1024 * IN_DIM_;
    for (int idx = bidx(); idx < 848; idx += gdim()) {
        if (idx < 640) { const int nt = idx >> 4, kt = idx & 15; const int n0 = nt * 256, so = n0 < 4096 ? n0 : n0 + 8;
            transpose_tile(tile, w_in + (size_t)kt * 64 * IN_DIM_ + so, IN_DIM_, (bf16_t*)(p.ws + OFF_WINT) + (size_t)n0 * 1024 + kt * 64, 1024); }
        else if (idx < 768) { const int j = idx - 640, k = j >> 5, r = j & 31, dt = r >> 3, wt = r & 7;
            transpose_tile(tile, p.w_branch + ((size_t)(layer * 4 + k) * 512 + wt * 64) * 1024 + dt * 256, 1024, (bf16_t*)(p.ws + OFF_WBT) + ((size_t)k * 1024 + dt * 256) * 512 + wt * 64, 512); }
        else if (idx < 832) { const int j = idx - 768, nt = j >> 4, kt = j & 15;
            transpose_tile(tile, p.w_out + ((size_t)layer * 1024 + kt * 64) * 1024 + nt * 256, 1024, (bf16_t*)(p.ws + OFF_WOUTT) + (size_t)nt * 256 * 1024 + kt * 64, 1024); }
        else { const int j = idx - 832, nt = j >> 3, kt = j & 7;
            transpose_tile(tile, p.w_glu + ((size_t)layer * 512 + kt * 64) * 512 + nt * 256, 512, (bf16_t*)(p.ws + OFF_WGLUT) + (size_t)nt * 256 * 512 + kt * 64, 512); }
    }
}

__device__ void phase_s5_tables(const P& p, int layer, char* smem) {
    float* pwr = (float*)smem;
    float* pwi = pwr + 64 * 17;
    float* bbr = pwi + 64 * 17;
    float* bbi = bbr + 1024;
    float* cr = bbi + 1024;
    float* ci = cr + 1024;
    float* kern = ci + 1024;
    const int tid = tidx();
    for (int job = bidx(); job < 256; job += gdim()) {
        const int g = job >> 3, part = job & 7;
        const int lg = layer * 32 + g;
        if (tid < 64) {
            const int n = tid;
            const float step = expf(p.log_step[lg]);
            const float lr = p.lam_re[lg * 64 + n], li = p.lam_im[lg * 64 + n];
            const float mag = expf(lr * step); float sn, cs; sincosf(li * step, &sn, &cs);
            const float abr = mag * cs, abi = mag * sn, den = lr * lr + li * li, nr = abr - 1.0f;
            const float cre = (nr * lr + abi * li) / den, cim = (abi * lr - nr * li) / den;
            double pr = 1.0, pi = 0.0; const double ar = (double)abr, ai = (double)abi;
            for (int j = 0; j <= 16; ++j) { pwr[n * 17 + j] = (float)pr; pwi[n * 17 + j] = (float)pi; const double t0 = pr * ar - pi * ai, t1 = pr * ai + pi * ar; pr = t0; pi = t1; }
            if (part == 0) { float* aq = (float*)(p.ws + OFF_AQ) + (g * 64 + n) * 2; aq[0] = pwr[n * 17 + 16]; aq[1] = pwi[n * 17 + 16]; }
            for (int q = 0; q < 16; ++q) { const float br = p.b_re[((size_t)lg * 64 + n) * 16 + q], bi = p.b_im[((size_t)lg * 64 + n) * 16 + q];
                bbr[n * 16 + q] = cre * br - cim * bi; bbi[n * 16 + q] = cre * bi + cim * br; }
        }
        for (int i = tid; i < 1024; i += 512) { cr[i] = p.c_re[(size_t)lg * 1024 + i]; ci[i] = p.c_im[(size_t)lg * 1024 + i]; }
        __syncthreads();
        const int nlag = 2 * part + 2;
        for (int o = tid; o < nlag * 64; o += 512) { const int j = o >> 6, pp = (o >> 2) & 15, q4 = (o & 3) * 4; f32x4 s4 = (f32x4){0.f, 0.f, 0.f, 0.f};
            for (int n = 0; n < 64; ++n) { const float wr_ = pwr[n * 17 + j], wi_ = pwi[n * 17 + j], c_r = cr[pp * 64 + n], c_i = ci[pp * 64 + n];
                const float dr_ = c_r * wr_ - c_i * wi_, di_ = c_r * wi_ + c_i * wr_;
                const f32x4 br = *(const f32x4*)(bbr + n * 16 + q4), bi = *(const f32x4*)(bbi + n * 16 + q4);
                s4 += dr_ * br - di_ * bi; }
            *(f32x4*)(kern + j * 256 + pp * 16 + q4) = s4; }
        __syncthreads();
        bf16_t* b2 = (bf16_t*)(p.ws + OFF_B2TAB) + (size_t)g * 256 * 384;
        for (int i = tid; i < 32 * 384; i += 512) { const int idx = part * 32 * 384 + i; const int r = idx / 384, k = idx - r * 384, t = r >> 4, pp = r & 15; float v;
            if (k < 64) v = cr[pp * 64 + k] * pwr[k * 17 + t + 1] - ci[pp * 64 + k] * pwi[k * 17 + t + 1];
            else if (k < 128) { const int n = k - 64; v = -(cr[pp * 64 + n] * pwi[n * 17 + t + 1] + ci[pp * 64 + n] * pwr[n * 17 + t + 1]); }
            else { const int s_ = (k - 128) >> 4, q = (k - 128) & 15; v = s_ <= t ? kern[(t - s_) * 256 + pp * 16 + q] : 0.f; }
            b2[idx] = f2bf(v); }
        bf16_t* gt = (bf16_t*)(p.ws + OFF_GTAB) + (size_t)g * 128 * 256;
        for (int i = tid; i < 16 * 256; i += 512) { const int idx = part * 16 * 256 + i; const int np = idx >> 8, kk = idx & 255, s_ = kk >> 4, q = kk & 15, n = np & 63;
            const float wr_ = pwr[n * 17 + 15 - s_], wi_ = pwi[n * 17 + 15 - s_], br = bbr[n * 16 + q], bi = bbi[n * 16 + q];
            gt[idx] = f2bf(np < 64 ? (wr_ * br - wi_ * bi) : (wr_ * bi + wi_ * br)); }
        if (g == 31) { bf16_t* pad = (bf16_t*)(p.ws + OFF_GTAB) + (size_t)32 * 128 * 256 + part * 16 * 256; for (int i = tid; i < 16 * 256; i += 512) pad[i] = 0; }
        __syncthreads();
    }
}

__device__ __forceinline__ float wave_sum(float v) {
#pragma unroll
    for (int o = 32; o > 0; o >>= 1) v += __shfl_xor(v, o, 64);
    return v;
}

__device__ void phase_rmsnorm_h(const P& p, int layer, const float* xin, char* smem) {
    const int tid = tidx(), wid = tid >> 6, lane = tid & 63;
    const float* w_in = p.w_in + (size_t)layer * 1024 * IN_DIM_;
    f32x4 wq[16][2];
#pragma unroll
    for (int j = 0; j < 4; ++j)
#pragma unroll
        for (int e = 0; e < 4; ++e) { const size_t k = (size_t)(j * 256 + lane * 4 + e); wq[j * 4 + e][0] = *(const f32x4*)(w_in + k * IN_DIM_ + 4096); wq[j * 4 + e][1] = *(const f32x4*)(w_in + k * IN_DIM_ + 4100); }
    const float* nw = p.norm_w + layer * 1024;
    bf16_t* h = (bf16_t*)(p.ws + OFF_H); float* dtraw = (float*)(p.ws + OFF_DTRAW);
    f32x4 wv[4];
#pragma unroll
    for (int j = 0; j < 4; ++j) wv[j] = *(const f32x4*)(nw + j * 256 + lane * 4);
    for (int row0 = (bidx() * 8 + wid) * 2; row0 < T_; row0 += gdim() * 16) {
        f32x4 v[2][4]; float ss[2] = {0.f, 0.f};
#pragma unroll
        for (int r = 0; r < 2; ++r)
#pragma unroll
            for (int j = 0; j < 4; ++j) v[r][j] = *(const f32x4*)(xin + (size_t)(row0 + r) * 1024 + j * 256 + lane * 4);
#pragma unroll
        for (int r = 0; r < 2; ++r)
#pragma unroll
            for (int j = 0; j < 4; ++j) ss[r] += v[r][j][0] * v[r][j][0] + v[r][j][1] * v[r][j][1] + v[r][j][2] * v[r][j][2] + v[r][j][3] * v[r][j][3];
        ss[0] = wave_sum(ss[0]); ss[1] = wave_sum(ss[1]);
#pragma unroll
        for (int r = 0; r < 2; ++r) {
            const float rstd = rsqrtf(ss[r] * (1.0f / 1024.0f) + 1e-6f);
            float dacc[8];
#pragma unroll
            for (int e = 0; e < 8; ++e) dacc[e] = 0.f;
#pragma unroll
            for (int j = 0; j < 4; ++j) { const f32x4 hv = v[r][j] * rstd * wv[j];
                u32x2 o; o[0] = cvt_pk_bf16(hv[0], hv[1]); o[1] = cvt_pk_bf16(hv[2], hv[3]);
                *(u32x2*)(h + (size_t)(row0 + r) * 1024 + j * 256 + lane * 4) = o;
#pragma unroll
                for (int e = 0; e < 4; ++e) { const f32x4 w0 = wq[j * 4 + e][0], w1 = wq[j * 4 + e][1];
#pragma unroll
                    for (int q = 0; q < 4; ++q) { dacc[q] += hv[e] * w0[q]; dacc[4 + q] += hv[e] * w1[q]; } }
            }
            const bool h32 = (lane & 32) != 0, h16 = (lane & 16) != 0, h8 = (lane & 8) != 0;
            float a4[4];
#pragma unroll
            for (int e = 0; e < 4; ++e) { const float send = h32 ? dacc[e] : dacc[4 + e]; const float keep = h32 ? dacc[4 + e] : dacc[e]; a4[e] = keep + __shfl_xor(send, 32, 64); }
            float a2[2];
#pragma unroll
            for (int e = 0; e < 2; ++e) { const float send = h16 ? a4[e] : a4[2 + e]; const float keep = h16 ? a4[2 + e] : a4[e]; a2[e] = keep + __shfl_xor(send, 16, 64); }
            float a1; { const float send = h8 ? a2[0] : a2[1]; const float keep = h8 ? a2[1] : a2[0]; a1 = keep + __shfl_xor(send, 8, 64); }
            a1 += __shfl_xor(a1, 4, 64); a1 += __shfl_xor(a1, 2, 64); a1 += __shfl_xor(a1, 1, 64);
            if ((lane & 7) == 0) { const int e = (h32 ? 4 : 0) + (h16 ? 2 : 0) + (h8 ? 1 : 0); dtraw[(size_t)(row0 + r) * 8 + e] = a1; }
        }
    }
    __syncthreads();
}

__device__ void phase_final_norm(const P& p) {
    const int tid = tidx(), wid = tid >> 6, lane = tid & 63;
    f32x4 wv[4];
#pragma unroll
    for (int j = 0; j < 4; ++j) wv[j] = *(const f32x4*)(p.final_w + j * 256 + lane * 4);
    const int rstep = gdim() * 16;
    f32x4 vn[2][4];
    { const int r0_ = (bidx() * 8 + wid) * 2;
#pragma unroll
        for (int r = 0; r < 2; ++r)
#pragma unroll
            for (int j = 0; j < 4; ++j) vn[r][j] = *(const f32x4*)(p.out + (size_t)(r0_ + r) * 1024 + j * 256 + lane * 4); }
    for (int row0 = (bidx() * 8 + wid) * 2; row0 < T_; row0 += rstep) {
        f32x4 v[2][4]; float ss[2] = {0.f, 0.f};
#pragma unroll
        for (int r = 0; r < 2; ++r)
#pragma unroll
            for (int j = 0; j < 4; ++j) v[r][j] = vn[r][j];
        { const int rn = row0 + rstep < T_ ? row0 + rstep : row0;
#pragma unroll
            for (int r = 0; r < 2; ++r)
#pragma unroll
                for (int j = 0; j < 4; ++j) vn[r][j] = *(const f32x4*)(p.out + (size_t)(rn + r) * 1024 + j * 256 + lane * 4); }
#pragma unroll
        for (int r = 0; r < 2; ++r)
#pragma unroll
            for (int j = 0; j < 4; ++j) ss[r] += v[r][j][0] * v[r][j][0] + v[r][j][1] * v[r][j][1] + v[r][j][2] * v[r][j][2] + v[r][j][3] * v[r][j][3];
        ss[0] = wave_sum(ss[0]); ss[1] = wave_sum(ss[1]);
#pragma unroll
        for (int r = 0; r < 2; ++r) { const float rstd = rsqrtf(ss[r] * (1.0f / 1024.0f) + 1e-6f);
#pragma unroll
            for (int j = 0; j < 4; ++j) *(f32x4*)(p.out + (size_t)(row0 + r) * 1024 + j * 256 + lane * 4) = v[r][j] * rstd * wv[j]; }
    }
}

__device__ void phase_sgu(const P& p, int layer, char* smem, int task0, int tstride) {
    bf16_t* vnT = (bf16_t*)smem;
    float* hs = (float*)(smem + 8 * 64 * LDP * 2);
    float* rs = hs + 8 * 128 * 2;
    const int tid = tidx(), w = tid >> 6, lane = tid & 63;
    const bf16_t* vbuf = (const bf16_t*)(p.ws + OFF_SGUV); const bf16_t* gbuf = (const bf16_t*)(p.ws + OFF_SGUG); bf16_t* ubuf = (bf16_t*)(p.ws + OFF_SGUU);
    const float* lnw = p.ln_w + layer * 512 + w * 64; const float* lnb = p.ln_b + layer * 512 + w * 64;
    const float* Wm = p.sgu_w + ((size_t)layer * 8 + w) * 128 * 128; const float* bs = p.sgu_b + (layer * 8 + w) * 128;
    for (int task = task0; task < 128; task += tstride) {
        const size_t tok0 = (size_t)task * 128;
        const int r8 = lane >> 3, e0 = (lane & 7) * 8;
        bf16_t* my = vnT + (size_t)w * 64 * LDP;
#pragma unroll 1
        for (int hb = 0; hb < 2; ++hb) {
        u32x4 vraw[8];
#pragma unroll
        for (int it = 0; it < 8; ++it) vraw[it] = *(const u32x4*)(vbuf + (tok0 + (hb * 8 + it) * 8 + r8) * 512 + w * 64 + e0);
#pragma unroll
        for (int it = 0; it < 8; ++it) { const int s = (hb * 8 + it) * 8 + r8;
            f32x4 a, b; unpack8(vraw[it], a, b);
            float sm = 0.f, sq = 0.f;
#pragma unroll
            for (int j = 0; j < 4; ++j) { const float x0 = geluf_(a[j]), x1 = geluf_(b[j]); sm += x0 + x1; sq += x0 * x0 + x1 * x1;
                my[xrow(e0 + j) * LDP + s] = f2bf(x0); my[xrow(e0 + 4 + j) * LDP + s] = f2bf(x1); }
#pragma unroll
            for (int o = 1; o < 8; o <<= 1) { sm += __shfl_xor(sm, o, 64); sq += __shfl_xor(sq, o, 64); }
            if ((lane & 7) == 0) { hs[(w * 128 + s) * 2] = sm; hs[(w * 128 + s) * 2 + 1] = sq; }
        }
        }
        __syncthreads();
        if (tid < 128) { float sm = 0.f, sq = 0.f;
#pragma unroll
            for (int hh = 0; hh < 8; ++hh) { sm += hs[(hh * 128 + tid) * 2]; sq += hs[(hh * 128 + tid) * 2 + 1]; }
            const float mu = sm * (1.0f / 512.0f); const float var = fmaxf(sq * (1.0f / 512.0f) - mu * mu, 0.f);
            rs[tid * 2] = mu; rs[tid * 2 + 1] = rsqrtf(var + 1e-6f); }
        __syncthreads();
        {
            const f32x4 lw0 = *(const f32x4*)(lnw + e0), lw1 = *(const f32x4*)(lnw + e0 + 4), lb0 = *(const f32x4*)(lnb + e0), lb1 = *(const f32x4*)(lnb + e0 + 4);
#pragma unroll 4
            for (int it = 0; it < 16; ++it) { const int s = it * 8 + r8;
                const float mu = rs[s * 2], rstd = rs[s * 2 + 1];
#pragma unroll
                for (int j = 0; j < 4; ++j) { bf16_t* q0 = my + xrow(e0 + j) * LDP + s; bf16_t* q1 = my + xrow(e0 + 4 + j) * LDP + s;
                    *q0 = f2bf((bf2f(*q0) - mu) * rstd * lw0[j] + lb0[j]); *q1 = f2bf((bf2f(*q1) - mu) * rstd * lw1[j] + lb1[j]); }
            }
        }
        __syncthreads();
        {
            const int fr = lane & 15, kq = lane >> 4;
            f32x4 wq[4][2]; u32x2 uq[4], gq[4]; float btq;
#define SGU_LOAD(NT) do { const int t_ = (NT) * 16 + fr; \
                _Pragma("unroll") for (int ks = 0; ks < 4; ++ks) { wq[ks][0] = *(const f32x4*)(Wm + (size_t)t_ * 128 + ks * 32 + kq * 8); wq[ks][1] = *(const f32x4*)(Wm + (size_t)t_ * 128 + ks * 32 + kq * 8 + 4); } \
                _Pragma("unroll") for (int mt = 0; mt < 4; ++mt) { const size_t o_ = (tok0 + t_) * 512 + w * 64 + mt * 16 + kq * 4; uq[mt] = *(const u32x2*)(ubuf + o_); gq[mt] = *(const u32x2*)(gbuf + o_); } \
                btq = bs[t_]; } while (0)
            SGU_LOAD(0);
#pragma unroll 1
            for (int nt = 0; nt < 8; ++nt) {
                f32x4 acc[4];
#pragma unroll
                for (int mt = 0; mt < 4; ++mt) acc[mt] = (f32x4){0.f, 0.f, 0.f, 0.f};
                const int t = nt * 16 + fr;
                bf16x8 bfr[4];
#pragma unroll
                for (int ks = 0; ks < 4; ++ks) { const int s0 = ks * 32 + kq * 8; f32x4 m0, m1;
#pragma unroll
                    for (int j = 0; j < 4; ++j) { m0[j] = (s0 + j <= t) ? wq[ks][0][j] : 0.f; m1[j] = (s0 + 4 + j <= t) ? wq[ks][1][j] : 0.f; }
                    const u32x4 bw = pack8(m0, m1); bfr[ks] = *(const bf16x8*)&bw; }
                u32x2 uc[4], gc[4]; const float bt = btq;
#pragma unroll
                for (int mt = 0; mt < 4; ++mt) { uc[mt] = uq[mt]; gc[mt] = gq[mt]; }
                if (nt < 7) SGU_LOAD(nt + 1);
#pragma unroll
                for (int ks = 0; ks < 4; ++ks) if (ks <= (nt >> 1)) {
                    const int s0 = ks * 32 + kq * 8;
#pragma unroll
                    for (int mt = 0; mt < 4; ++mt) acc[mt] = mma16(ldfrag(my, xrow(mt * 16 + fr), s0), bfr[ks], acc[mt]);
                }
                const size_t tok = tok0 + t;
#pragma unroll
                for (int mt = 0; mt < 4; ++mt) { const size_t o = tok * 512 + w * 64 + mt * 16 + kq * 4;
                    const u32x2 uu = uc[mt], gg = gc[mt];
                    const float u0 = bflo(uu[0]), u1 = bfhi(uu[0]), u2 = bflo(uu[1]), u3 = bfhi(uu[1]);
                    const float g0 = bflo(gg[0]), g1 = bfhi(gg[0]), g2 = bflo(gg[1]), g3 = bfhi(gg[1]);
                    u32x2 r; r[0] = cvt_pk_bf16(u0 * g0 * (acc[mt][0] + bt) * sig2f_(geluarg_(u0), g0), u1 * g1 * (acc[mt][1] + bt) * sig2f_(geluarg_(u1), g1));
                    r[1] = cvt_pk_bf16(u2 * g2 * (acc[mt][2] + bt) * sig2f_(geluarg_(u2), g2), u3 * g3 * (acc[mt][3] + bt) * sig2f_(geluarg_(u3), g3));
                    *(u32x2*)(ubuf + o) = r; }
            }
#undef SGU_LOAD
        }
        __syncthreads();
    }
}

__device__ void phase_m2_local(const P& p, int layer, char* smem) {
    bf16_t* Cs = (bf16_t*)smem;
    bf16_t* Bs = Cs + 128 * LDP;
    bf16_t* BTs = Bs + 128 * LDP;
    bf16_t* xT = BTs + 128 * LDP;
    float* dts4 = (float*)(xT + 64 * LDP);
    float* acs4 = dts4 + 512;
    float* das4 = acs4 + 512;
    const int tid = tidx(), w = tid >> 6, lane = tid & 63, fr = lane & 15, kq = lane >> 4;
    const bf16_t* xbc = (const bf16_t*)(p.ws + OFF_XBC); const float* dtraw = (const float*)(p.ws + OFF_DTRAW);
    const float* cw = p.conv_w + (size_t)layer * 4 * 1024; const float* cbv = p.conv_b + layer * 1024;
    for (int task = bidx(); task < 256; task += gdim()) {
        const int grp = task & 1, c = (task >> 1) & 15, b = task >> 5;
        const size_t tok0 = (size_t)b * SEQ_ + c * 128;
        {
            const int h4 = tid >> 7, l = tid & 127, hd = grp * 4 + h4;
            const float aneg = -__expf(p.a_log[layer * 8 + hd]);
            const float dr = dtraw[(tok0 + l) * 8 + hd] + p.dt_bias[layer * 8 + hd]; const float e_ = __expf(dr), u_ = 1.0f + e_; const float dt = dr > 20.f ? dr : (u_ == 1.0f ? e_ : __logf(u_) * e_ * __builtin_amdgcn_rcpf(u_ - 1.0f));
            dts4[tid] = dt; das4[tid] = dt * aneg;
            float s_ = dt * aneg;
#pragma unroll
            for (int o = 1; o < 64; o <<= 1) { const float t = __shfl_up(s_, o, 64); if ((tid & 63) >= o) s_ += t; }
            __syncthreads();
            if (l >= 64) { float tot = 0.f; const float* dh = das4 + h4 * 128;
                for (int j = 0; j < 64; j += 4) tot += dh[j] + dh[j + 1] + dh[j + 2] + dh[j + 3];
                s_ += tot; }
            acs4[tid] = s_;
            ((float*)(p.ws + OFF_EACS))[(tok0 + l) * 8 + hd] = __expf(s_);
            if (l == 127) ((float*)(p.ws + OFF_ACH))[(b * 16 + c) * 8 + hd] = s_;
        }
        {
            const int cgi = tid & 31, run = tid >> 5, l0 = run * 8;
            const int ch = cgi < 16 ? 512 + grp * 128 + cgi * 8 : 768 + grp * 128 + (cgi - 16) * 8, n0 = (cgi & 15) * 8;
            f32x4 wk[4][2], bias0 = *(const f32x4*)(cbv + ch), bias1 = *(const f32x4*)(cbv + ch + 4);
#pragma unroll
            for (int k = 0; k < 4; ++k) { wk[k][0] = *(const f32x4*)(cw + k * 1024 + ch); wk[k][1] = *(const f32x4*)(cw + k * 1024 + ch + 4); }
            f32x4 h0[3], h1[3];
#pragma unroll
            for (int j = 0; j < 3; ++j) { const int l = l0 - 3 + j; const bool ok = c * 128 + l >= 0;
                u32x4 rw = *(const u32x4*)(xbc + (tok0 + (ok ? l : 0)) * 1024 + ch); if (!ok) rw = (u32x4){0u, 0u, 0u, 0u};
                unpack8(rw, h0[j], h1[j]); }
#pragma unroll 1
            for (int hb = 0; hb < 2; ++hb) {
            u32x4 raw[4];
#pragma unroll
            for (int i = 0; i < 4; ++i) raw[i] = *(const u32x4*)(xbc + (tok0 + l0 + hb * 4 + i) * 1024 + ch);
#pragma unroll
            for (int i = 0; i < 4; ++i) { const int l = l0 + hb * 4 + i;
                f32x4 c0, c1; unpack8(raw[i], c0, c1);
                f32x4 o0 = bias0 + wk[0][0] * h0[0] + wk[1][0] * h0[1] + wk[2][0] * h0[2] + wk[3][0] * c0;
                f32x4 o1 = bias1 + wk[0][1] * h1[0] + wk[1][1] * h1[1] + wk[2][1] * h1[2] + wk[3][1] * c1;
                h0[0] = h0[1]; h0[1] = h0[2]; h0[2] = c0; h1[0] = h1[1]; h1[1] = h1[2]; h1[2] = c1;
#pragma unroll
                for (int j = 0; j < 4; ++j) { o0[j] = siluf_(o0[j]); o1[j] = siluf_(o1[j]); }
                const u32x4 pk = pack8(o0, o1);
                if (cgi < 16) *(u32x4*)(Bs + l * LDP + n0) = pk;
                else { *(u32x4*)(Cs + l * LDP + n0) = pk; *(u32x4*)((bf16_t*)(p.ws + OFF_CCONV) + (tok0 + l) * 256 + grp * 128 + n0) = pk; }
            }
            }
        }
        __syncthreads();
        const int ntile = (w | 1) + 1;
        u32x2 g16[8];
        {
            f32x4 g[8];
#pragma unroll
            for (int st = 0; st < 8; ++st) g[st] = (f32x4){0.f, 0.f, 0.f, 0.f};
#pragma unroll
            for (int ks = 0; ks < 4; ++ks) { const bf16x8 a = ldfrag(Cs, w * 16 + fr, ks * 32 + kq * 8);
#pragma unroll
                for (int st = 0; st < 8; ++st) if (st < ntile) g[st] = mma16(a, ldfrag(Bs, st * 16 + fr, ks * 32 + kq * 8), g[st]); }
#pragma unroll
            for (int st = 0; st < 8; ++st) { g16[st][0] = cvt_pk_bf16(g[st][0], g[st][1]); g16[st][1] = cvt_pk_bf16(g[st][2], g[st][3]); }
        }
#pragma unroll 1
        for (int h4 = 0; h4 < 4; ++h4) {
            const int hd = grp * 4 + h4;
            const float* dts = dts4 + h4 * 128; const float* acs = acs4 + h4 * 128;
            __syncthreads();
            const float alast = acs[127];
            {
                const int cgx = tid & 7, run = tid >> 3, l0 = run * 2, ch = hd * 64 + cgx * 8, p0 = cgx * 8;
                f32x4 wk[4][2], bias0 = *(const f32x4*)(cbv + ch), bias1 = *(const f32x4*)(cbv + ch + 4);
#pragma unroll
                for (int k = 0; k < 4; ++k) { wk[k][0] = *(const f32x4*)(cw + k * 1024 + ch); wk[k][1] = *(const f32x4*)(cw + k * 1024 + ch + 4); }
                f32x4 r0[5], r1[5];
#pragma unroll
                for (int j = 0; j < 5; ++j) { const int l = l0 - 3 + j; const bool ok = c * 128 + l >= 0;
                    u32x4 rw = *(const u32x4*)(xbc + (tok0 + (ok ? l : 0)) * 1024 + ch); if (!ok) rw = (u32x4){0u, 0u, 0u, 0u};
                    unpack8(rw, r0[j], r1[j]); }
#pragma unroll
                for (int i = 0; i < 2; ++i) { const int l = l0 + i;
                    f32x4 o0 = bias0 + wk[0][0] * r0[i] + wk[1][0] * r0[i + 1] + wk[2][0] * r0[i + 2] + wk[3][0] * r0[i + 3];
                    f32x4 o1 = bias1 + wk[0][1] * r1[i] + wk[1][1] * r1[i + 1] + wk[2][1] * r1[i + 2] + wk[3][1] * r1[i + 3];
#pragma unroll
                    for (int j = 0; j < 4; ++j) { xT[(p0 + j) * LDP + l] = f2bf(siluf_(o0[j])); xT[(p0 + 4 + j) * LDP + l] = f2bf(siluf_(o1[j])); } }
            }
#pragma unroll
            for (int i = 0; i < 4; ++i) { const int pr = tid + i * 512, l = pr & 127, n0 = (pr >> 7) * 8;
                f32x4 b0, b1; unpack8(*(const u32x4*)(Bs + l * LDP + n0), b0, b1);
                const float sc = dts[l] * __expf(alast - acs[l]);
#pragma unroll
                for (int j = 0; j < 4; ++j) { BTs[(n0 + j) * LDP + l] = f2bf(b0[j] * sc); BTs[(n0 + 4 + j) * LDP + l] = f2bf(b1[j] * sc); } }
#pragma unroll
            for (int st = 0; st < 8; ++st) if (st < ntile) { const int s_ = st * 16 + fr; const float as_ = acs[s_], ds_ = dts[s_];
#pragma unroll
                for (int r = 0; r < 4; ++r) { const int l = w * 16 + kq * 4 + r; const float gv = (r & 1) ? bfhi(g16[st][r >> 1]) : bflo(g16[st][r >> 1]); const float v = (s_ <= l) ? gv * __expf(acs[l] - as_) * ds_ : 0.f; Cs[l * LDP + s_] = f2bf(v); } }
            __syncthreads();
            {
                f32x4 y[4];
#pragma unroll
                for (int mt = 0; mt < 4; ++mt) y[mt] = (f32x4){0.f, 0.f, 0.f, 0.f};
                for (int ks = 0; ks <= (w >> 1); ++ks) { const bf16x8 bfrag = ldfrag(Cs, w * 16 + fr, ks * 32 + kq * 8);
#pragma unroll
                    for (int mt = 0; mt < 4; ++mt) y[mt] = mma16(ldfrag(xT, mt * 16 + fr, ks * 32 + kq * 8), bfrag, y[mt]); }
                const int l = w * 16 + fr; const float dd = p.m2_d[layer * 8 + hd];
                bf16_t* yp = (bf16_t*)(p.ws + OFF_YPART) + (tok0 + l) * 512 + hd * 64;
#pragma unroll
                for (int mt = 0; mt < 4; ++mt) { const int p0 = mt * 16 + kq * 4; f32x4 v;
#pragma unroll
                    for (int r = 0; r < 4; ++r) v[r] = y[mt][r] + dd * bf2f(xT[(p0 + r) * LDP + l]);
                    u32x2 o; o[0] = cvt_pk_bf16(v[0], v[1]); o[1] = cvt_pk_bf16(v[2], v[3]); *(u32x2*)(yp + p0) = o; }
            }
            {
                f32x4 st_[4];
#pragma unroll
                for (int pt = 0; pt < 4; ++pt) st_[pt] = (f32x4){0.f, 0.f, 0.f, 0.f};
#pragma unroll
                for (int ks = 0; ks < 4; ++ks) { const bf16x8 a = ldfrag(BTs, w * 16 + fr, ks * 32 + kq * 8);
#pragma unroll
                    for (int pt = 0; pt < 4; ++pt) st_[pt] = mma16(a, ldfrag(xT, pt * 16 + fr, ks * 32 + kq * 8), st_[pt]); }
                bf16_t* sb = (bf16_t*)(p.ws + OFF_M2ST) + (size_t)((b * 16 + c) * 8 + hd) * 64 * 128;
#pragma unroll
                for (int pt = 0; pt < 4; ++pt) { const int pp = pt * 16 + fr, n0 = w * 16 + kq * 4;
                    u32x2 o; o[0] = cvt_pk_bf16(st_[pt][0], st_[pt][1]); o[1] = cvt_pk_bf16(st_[pt][2], st_[pt][3]); *(u32x2*)(sb + pp * 128 + n0) = o; }
            }
        }
        __syncthreads();
    }
}

__device__ __forceinline__ void phase_m2_carry(const P& p, int vb, int nvb) {
    const int tid = tidx();
    for (int idx = vb * 512 + tid; idx < 8 * 8 * 64 * 32; idx += nvb * 512) {
        const int n4 = idx & 31, pp = (idx >> 5) & 63, hd = (idx >> 11) & 7, b = idx >> 14;
        bf16_t* base = (bf16_t*)(p.ws + OFF_M2ST) + (size_t)(b * 16 * 8 + hd) * 8192 + pp * 128 + n4 * 4;
        const float* ach = (const float*)(p.ws + OFF_ACH) + b * 16 * 8 + hd;
        u32x2 ld[16];
#pragma unroll
        for (int c = 0; c < 16; ++c) ld[c] = *(const u32x2*)(base + (size_t)c * 8 * 8192);
        float decq[16];
#pragma unroll
        for (int c = 0; c < 16; ++c) decq[c] = ach[c * 8];
        f32x4 S = (f32x4){0.f, 0.f, 0.f, 0.f};
#pragma unroll
        for (int c = 0; c < 16; ++c) { u32x2 o; o[0] = cvt_pk_bf16(S[0], S[1]); o[1] = cvt_pk_bf16(S[2], S[3]); *(u32x2*)(base + (size_t)c * 8 * 8192) = o;
            const float dec = __expf(decq[c]);
            S[0] = dec * S[0] + bflo(ld[c][0]); S[1] = dec * S[1] + bfhi(ld[c][0]); S[2] = dec * S[2] + bflo(ld[c][1]); S[3] = dec * S[3] + bfhi(ld[c][1]); }
    }
}
__device__ void s5_carry_unit(const P& p, char* smem, int g, int pm) {
    const int tid = tidx();
    float* ex = (float*)(smem + 65536);
    const bf16_t* sloc = (const bf16_t*)smem;
    __syncthreads();
    for (int bb = 0; bb < 2; ++bb) {
        const int b = pm * 2 + bb, n = tid & 63, seg = tid >> 6;
        const float aqr = ((const float*)(p.ws + OFF_AQ))[(g * 64 + n) * 2], aqi = ((const float*)(p.ws + OFF_AQ))[(g * 64 + n) * 2 + 1];
        const bf16_t* sl = sloc + (bb * 128 + seg * 16) * 128;
        bf16_t* a2 = (bf16_t*)(p.ws + OFF_A2) + ((size_t)g * 1024 + b * 128 + seg * 16) * 384;
        float lr[16], li[16];
#pragma unroll
        for (int j = 0; j < 16; ++j) { lr[j] = bf2f(sl[j * 128 + n]); li[j] = bf2f(sl[j * 128 + 64 + n]); }
        float sr = 0.f, si = 0.f;
#pragma unroll
        for (int j = 0; j < 16; ++j) { const float t0 = aqr * sr - aqi * si + lr[j], t1 = aqr * si + aqi * sr + li[j]; sr = t0; si = t1; }
        __syncthreads();
        ex[(seg * 64 + n) * 2] = sr; ex[(seg * 64 + n) * 2 + 1] = si;
        __syncthreads();
        float pr = aqr, pi = aqi;
#pragma unroll
        for (int j = 0; j < 4; ++j) { const float t0 = pr * pr - pi * pi, t1 = 2.f * pr * pi; pr = t0; pi = t1; }
        float cr_ = 0.f, ci_ = 0.f;
        for (int s_ = 0; s_ < seg; ++s_) { const float er = ex[(s_ * 64 + n) * 2], ei = ex[(s_ * 64 + n) * 2 + 1]; const float t0 = pr * cr_ - pi * ci_ + er, t1 = pr * ci_ + pi * cr_ + ei; cr_ = t0; ci_ = t1; }
        sr = cr_; si = ci_;
#pragma unroll
        for (int j = 0; j < 16; ++j) { a2[j * 384 + n] = f2bf(sr); a2[j * 384 + 64 + n] = f2bf(si);
            const float t0 = aqr * sr - aqi * si + lr[j], t1 = aqr * si + aqi * sr + li[j]; sr = t0; si = t1; }
    }
    asm volatile("s_waitcnt vmcnt(0)" ::: "memory");
    __syncthreads();
}

__device__ __forceinline__ void phase_m2_out(const P& p, int layer, char* smem, int task0, int tstride) {
    float* ssq = (float*)smem;
    float* rst = ssq + 512;
    const int tid = tidx(), w = tid >> 6, lane = tid & 63, fr = lane & 15, kq = lane >> 4, grp = w >> 2;
    const bf16_t* cc = (const bf16_t*)(p.ws + OFF_CCONV); const bf16_t* yp = (const bf16_t*)(p.ws + OFF_YPART); bf16_t* zb = (bf16_t*)(p.ws + OFF_M2Z);
    const float* eacs = (const float*)(p.ws + OFF_EACS); const float* nw = p.m2_norm_w + layer * 512 + w * 64;
    for (int task = task0; task < 256; task += tstride) {
        const int half = task & 1, c = (task >> 1) & 15, b = task >> 5;
        const size_t tok0 = (size_t)b * SEQ_ + c * 128 + half * 64;
        const bf16_t* sin_ = (const bf16_t*)(p.ws + OFF_M2ST) + (size_t)((b * 16 + c) * 8 + w) * 8192;
        f32x4 acc[4][4];
#pragma unroll
        for (int mt = 0; mt < 4; ++mt)
#pragma unroll
            for (int nt = 0; nt < 4; ++nt) acc[mt][nt] = (f32x4){0.f, 0.f, 0.f, 0.f};
#pragma unroll
        for (int ks = 0; ks < 4; ++ks) { bf16x8 a[4];
#pragma unroll
            for (int mt = 0; mt < 4; ++mt) a[mt] = *(const bf16x8*)(sin_ + (mt * 16 + fr) * 128 + ks * 32 + kq * 8);
#pragma unroll
            for (int nt = 0; nt < 4; ++nt) { const bf16x8 bb = *(const bf16x8*)(cc + (tok0 + nt * 16 + fr) * 256 + grp * 128 + ks * 32 + kq * 8);
#pragma unroll
                for (int mt = 0; mt < 4; ++mt) acc[mt][nt] = mma16(a[mt], bb, acc[mt][nt]); } }
        u32x2 yq[4][4], zq[4][4]; float eaq[4];
#pragma unroll
        for (int nt = 0; nt < 4; ++nt) { const size_t tok = tok0 + nt * 16 + fr; eaq[nt] = eacs[tok * 8 + w];
#pragma unroll
            for (int mt = 0; mt < 4; ++mt) { const size_t o = tok * 512 + w * 64 + mt * 16 + kq * 4; yq[nt][mt] = *(const u32x2*)(yp + o); zq[nt][mt] = *(const u32x2*)(zb + o); } }
#pragma unroll
        for (int nt = 0; nt < 4; ++nt) { const float ea = eaq[nt]; float ss = 0.f;
#pragma unroll
            for (int mt = 0; mt < 4; ++mt) {
                const u32x2 yy = yq[nt][mt], zz = zq[nt][mt];
                f32x4 v; v[0] = (bflo(yy[0]) + ea * acc[mt][nt][0]) * siluf_(bflo(zz[0])); v[1] = (bfhi(yy[0]) + ea * acc[mt][nt][1]) * siluf_(bfhi(zz[0]));
                v[2] = (bflo(yy[1]) + ea * acc[mt][nt][2]) * siluf_(bflo(zz[1])); v[3] = (bfhi(yy[1]) + ea * acc[mt][nt][3]) * siluf_(bfhi(zz[1]));
                acc[mt][nt] = v; ss += v[0] * v[0] + v[1] * v[1] + v[2] * v[2] + v[3] * v[3]; }
            ss += __shfl_xor(ss, 16, 64); ss += __shfl_xor(ss, 32, 64);
            if (kq == 0) ssq[w * 64 + nt * 16 + fr] = ss; }
        __syncthreads();
        if (tid < 64) { float s = 0.f;
#pragma unroll
            for (int hh = 0; hh < 8; ++hh) s += ssq[hh * 64 + tid];
            rst[tid] = rsqrtf(s * (1.0f / 512.0f) + 1e-6f); }
        __syncthreads();
        f32x4 wvn[4];
#pragma unroll
        for (int mt = 0; mt < 4; ++mt) wvn[mt] = *(const f32x4*)(nw + mt * 16 + kq * 4);
#pragma unroll
        for (int nt = 0; nt < 4; ++nt) { const size_t tok = tok0 + nt * 16 + fr; const float r = rst[nt * 16 + fr];
#pragma unroll
            for (int mt = 0; mt < 4; ++mt) { const int p0 = mt * 16 + kq * 4; const f32x4 v = acc[mt][nt] * r * wvn[mt];
                u32x2 o; o[0] = cvt_pk_bf16(v[0], v[1]); o[1] = cvt_pk_bf16(v[2], v[3]); *(u32x2*)(zb + tok * 512 + w * 64 + p0) = o; } }
        __syncthreads();
    }
}

__device__ __forceinline__ void phase_shortconv(const P& p, int layer, int vb, int nvb) {
    const bf16_t* cb = (const bf16_t*)(p.ws + OFF_SCC); const bf16_t* hb = (const bf16_t*)(p.ws + OFF_SCH); const bf16_t* gb = (const bf16_t*)(p.ws + OFF_SCG); bf16_t* bb = (bf16_t*)(p.ws + OFF_SCB);
    const float* cw = p.sc_w + (size_t)layer * 3 * 512;
    for (int idx = vb * 512 + tidx(); idx < (T_ / 8) * 64; idx += nvb * 512) {
        const int cgp = idx & 63, run = idx >> 6, ch = cgp * 8; const size_t t0 = (size_t)run * 8; const int lseq = (int)(t0 & (SEQ_ - 1));
        f32x4 w0[3], w1[3];
#pragma unroll
        for (int k = 0; k < 3; ++k) { w0[k] = *(const f32x4*)(cw + k * 512 + ch); w1[k] = *(const f32x4*)(cw + k * 512 + ch + 4); }
        f32x4 pa0[2], pa1[2];
#pragma unroll
        for (int j = 0; j < 2; ++j) { const bool ok = lseq - 2 + j >= 0; const size_t o = (ok ? t0 - 2 + j : t0) * 512 + ch;
            u32x4 wc_ = *(const u32x4*)(cb + o), wh_ = *(const u32x4*)(hb + o); if (!ok) { wc_ = (u32x4){0u, 0u, 0u, 0u}; wh_ = wc_; }
            f32x4 c0, c1, h0, h1; unpack8(wc_, c0, c1); unpack8(wh_, h0, h1); pa0[j] = c0 * h0; pa1[j] = c1 * h1; }
#pragma unroll
        for (int hbt = 0; hbt < 2; ++hbt) {
            u32x4 rc[4], rh[4], rb[4], rg[4];
#pragma unroll
            for (int i = 0; i < 4; ++i) { const size_t o = (t0 + hbt * 4 + i) * 512 + ch; rc[i] = *(const u32x4*)(cb + o); rh[i] = *(const u32x4*)(hb + o); rb[i] = *(const u32x4*)(bb + o); rg[i] = *(const u32x4*)(gb + o); }
#pragma unroll
            for (int i = 0; i < 4; ++i) { const size_t o = (t0 + hbt * 4 + i) * 512 + ch;
                f32x4 c0, c1, h0, h1, b0, b1, g0, g1; unpack8(rc[i], c0, c1); unpack8(rh[i], h0, h1); unpack8(rb[i], b0, b1); unpack8(rg[i], g0, g1);
                const f32x4 q0 = c0 * h0, q1 = c1 * h1;
                f32x4 y0 = b0 * (w0[0] * pa0[0] + w0[1] * pa0[1] + w0[2] * q0), y1 = b1 * (w1[0] * pa1[0] + w1[1] * pa1[1] + w1[2] * q1);
#pragma unroll
                for (int j = 0; j < 4; ++j) { y0[j] *= siluf_(g0[j]); y1[j] *= siluf_(g1[j]); }
                *(u32x4*)(bb + o) = pack8(y0, y1);
                pa0[0] = pa0[1]; pa0[1] = q0; pa1[0] = pa1[1]; pa1[1] = q1; }
        }
    }
}

#define XB_TMO      128
#define XB_XCNT(j)  (256  + 64 * (j))
#define XB_XSUB(j)  (1280 + 64 * (j))
#define XB_XGEN(j)  (2304 + 64 * (j))
#define XB_TOP      3328
#define XB_TOPGEN   3392
#define XCD_BAR_WORDS 3456
#define XB_SPIN_CAP (1u << 20)
__device__ __forceinline__ unsigned xb_ld(unsigned* p)              { return __hip_atomic_load(p, __ATOMIC_RELAXED, __HIP_MEMORY_SCOPE_AGENT); }
__device__ __forceinline__ unsigned xb_add(unsigned* p, unsigned v) { return __hip_atomic_fetch_add(p, v, __ATOMIC_RELAXED, __HIP_MEMORY_SCOPE_AGENT); }
__device__ __forceinline__ unsigned xb_xcc_id() { return (unsigned)__builtin_amdgcn_s_getreg((3 << 11) | 20) & 0xFu; }
#define XB_SPIN(cond, bar) do { unsigned _sp = 0; while (cond) { __builtin_amdgcn_s_sleep(1); \
    if ((++_sp & 255u) == 0u) { if (xb_ld(&(bar)[XB_TMO])) break; if (_sp > XB_SPIN_CAP) { atomicAdd(&(bar)[XB_TMO], 1u); break; } } } } while (0)
struct XcdBarrier { unsigned* bar; unsigned x; volatile LAS unsigned* st; };
__device__ __forceinline__ XcdBarrier xcd_barrier_post(unsigned* bar, volatile LAS unsigned* st) {
    XcdBarrier b; b.bar = bar; b.x = xb_xcc_id(); b.st = st;
    if (__builtin_amdgcn_workitem_id_x() == 0) (void)xb_add(&bar[XB_XCNT(b.x)], 1u);
    return b;
}
__device__ __forceinline__ void xcd_barrier_complete(unsigned* bar, unsigned x, unsigned& nloc, unsigned& nx) {
    const unsigned G = (unsigned)gdim();
    unsigned sum, cnt, mine, sp = 0u;
    for (;;) {
        sum = 0u; cnt = 0u; mine = 0u;
        unsigned cv[16];
#pragma unroll
        for (unsigned j = 0; j < 16; ++j) cv[j] = xb_ld(&bar[XB_XCNT(j)]);
#pragma unroll
        for (unsigned j = 0; j < 16; ++j) { const unsigned c = cv[j]; sum += c; cnt += (c > 0u) ? 1u : 0u; mine = (j == x) ? c : mine; }
        if (sum == G) break;
        __builtin_amdgcn_s_sleep(1);
        if ((++sp & 255u) == 0u) { if (xb_ld(&bar[XB_TMO])) break; if (sp > XB_SPIN_CAP) { atomicAdd(&bar[XB_TMO], 1u); break; } }
    }
    nloc = mine > 0u ? mine : 1u; nx = cnt > 0u ? cnt : 1u;
}
__device__ __forceinline__ void xcd_barrier(const XcdBarrier& b) {
    asm volatile("s_waitcnt vmcnt(0)" ::: "memory");
    __syncthreads();
    if (__builtin_amdgcn_workitem_id_x() == 0) {
        unsigned* bar = b.bar;
        __builtin_amdgcn_s_waitcnt(0);
        unsigned nloc = b.st[0], nx = b.st[1];
        if (nloc == 0u) { xcd_barrier_complete(bar, b.x, nloc, nx); b.st[0] = nloc; b.st[1] = nx; }
        const unsigned old = xb_add(&bar[XB_XSUB(b.x)], 1u);
        const unsigned gen = old / nloc;
        if (old + 1u == (gen + 1u) * nloc) {
            __builtin_amdgcn_fence(__ATOMIC_RELEASE, "agent");
            asm volatile("s_waitcnt vmcnt(0)" ::: "memory");
            const unsigned og = xb_add(&bar[XB_TOP], 1u);
            const unsigned tg = og / nx;
            if (og + 1u == (tg + 1u) * nx) xb_add(&bar[XB_TOPGEN], 1u);
            else XB_SPIN(xb_ld(&bar[XB_TOPGEN]) == tg, bar);
            __builtin_amdgcn_fence(__ATOMIC_ACQUIRE, "agent");
            xb_add(&bar[XB_XGEN(b.x)], 1u);
            asm volatile("s_waitcnt vmcnt(0)" ::: "memory");
        } else {
            XB_SPIN(xb_ld(&bar[XB_XGEN(b.x)]) == gen, bar);
            __builtin_amdgcn_fence(__ATOMIC_ACQUIRE, "agent");
            asm volatile("s_waitcnt vmcnt(0)" ::: "memory");
        }
    }
    __syncthreads();
}


template <int PH> __device__ __forceinline__ void run_phase(const P& p, int layer, char* smem) {
    LAS unsigned char* lds = (LAS unsigned char*)smem;
    const int G = gdim(), c = bidx();
    const float* xin = layer == 0 ? p.x : p.out;
    if (PH == 0) { phase_prep_weights(p, layer, smem); phase_s5_tables(p, layer, smem); phase_rmsnorm_h(p, layer, xin, smem); }
    if (PH == 1) { SchedG1 S{p.ws + OFF_H, p.ws + OFF_WINT, G, c}; EpiG1 E{p.ws}; gemm_phase(lds, S, E); }
    if (PH == 2) {
        for (int L = c; L < 128; L += G) {
            { SchedS1 S{p.ws, 128, L}; EpiS1 E{}; gemm_phase(lds, S, E); }
            s5_carry_unit(p, smem, L >> 2, L & 3);
            { SchedS2 S{p.ws, 128, L}; EpiS2 E{p.ws, p.s5_d + layer * 512}; gemm_phase(lds, S, E); }
        }
        const bool split = G > 128; const int vb = split ? c - 128 : c, nvb = split ? G - 128 : G;
        phase_sgu(p, layer, smem, split ? (vb >= 0 ? vb : 128) : c, nvb);
        phase_m2_local(p, layer, smem);
        { const int vs = split ? (c < 128 ? c : -1) : c, nvs = split ? 128 : G; if (vs >= 0) phase_shortconv(p, layer, vs, nvs); } }
    if (PH == 3) { phase_m2_carry(p, c, G); }
    if (PH == 4) {
        { SchedGLU S{p.ws, G, c}; EpiGLU E{p.ws}; gemm_phase(lds, S, E); }
        { const bool split = G > 128; const int vb = split ? c - 128 : c, nvb = split ? G - 128 : G; if (vb >= 0) phase_m2_out(p, layer, smem, vb, nvb); } }
    if (PH == 6) { SchedP3 S{p.ws, G, c}; EpiP3 E{p.ws, p.merge_b + layer * 4096}; gemm_phase(lds, S, E); }
    if (PH == 7) { SchedP4 S{p.ws, G, c}; EpiP4 E{xin, p.out}; gemm_phase(lds, S, E); }
    if (PH == 8) { phase_final_norm(p); }
}

template <int PH> __global__ void __launch_bounds__(512, 2) k_phase(P p, int layer) {
    extern __shared__ __attribute__((aligned(16))) char smem[];
    run_phase<PH>(p, layer, smem);
}

#if MEGA
__global__ void __launch_bounds__(512, 2) k_mega(P p) {
    extern __shared__ __attribute__((aligned(16))) char smem[];
    cg::grid_group grid = cg::this_grid();
    if (p.ws == nullptr) grid.sync();
    volatile LAS unsigned* xbw = (volatile LAS unsigned*)(LAS unsigned char*)(smem + SMEM_BYTES - 16);
    if (__builtin_amdgcn_workitem_id_x() == 0) { xbw[0] = 0u; xbw[1] = 0u;
        const unsigned xcc = xb_xcc_id(), rank = xb_add((unsigned*)(p.ws + OFF_BAR) + 4 * xcc, 1u);
        xbw[2] = (unsigned)__builtin_amdgcn_workgroup_id_x();
        xbw[3] = rank * 8u + xcc; }
    __syncthreads();
    const XcdBarrier xb = xcd_barrier_post((unsigned*)(p.ws + OFF_BAR), xbw);
    for (int step = 0; step < 15; ++step) {
        P q = p;
        asm volatile("" : "+s"(q.ws), "+s"(q.out), "+s"(q.x));
        int layer = __builtin_amdgcn_readfirstlane(step / 7); const int ph = step - 7 * layer;
        asm volatile("" : "+s"(layer));
        if (step == 14) { run_phase<8>(q, 0, smem); break; }
        switch (ph) {
            case 0: run_phase<0>(q, layer, smem); break;
            case 1: run_phase<1>(q, layer, smem); break;
            case 2: run_phase<2>(q, layer, smem); break;
            case 3: run_phase<3>(q, layer, smem); break;
            case 4: run_phase<4>(q, layer, smem); break;
            case 5: run_phase<6>(q, layer, smem); break;
            default: run_phase<7>(q, layer, smem); break;
        }
        xcd_barrier(xb);
        if (step == 0) {
            if (__builtin_amdgcn_workitem_id_x() == 0) { bool ok = gdim() == 256;
                unsigned cv[16];
#pragma unroll
                for (unsigned j = 0; j < 16; ++j) cv[j] = xb_ld((unsigned*)(p.ws + OFF_BAR) + XB_XCNT(j));
#pragma unroll
                for (unsigned j = 0; j < 16; ++j) ok = ok && (cv[j] == (j < 8u ? 32u : 0u));
                if (ok) xbw[2] = xbw[3]; }
            __syncthreads();
        }
    }
}
#endif

template <int PH> static void launch_phase(const P& p, int layer, hipStream_t stream) {
    static bool attr = false;
    if (!attr) { hipFuncSetAttribute((const void*)k_phase<PH>, hipFuncAttributeMaxDynamicSharedMemorySize, SMEM_BYTES); attr = true; }
    hipLaunchKernelGGL(k_phase<PH>, dim3(256), dim3(512), SMEM_BYTES, stream, p, layer);
}

extern "C" void kernel_launch(void* const* d_in, const int* in_sizes, int n_in, void* d_out, int out_size, void* d_ws, size_t ws_size, hipStream_t stream) {
    if (ws_size < WS_NEED) { fprintf(stderr, "workspace too small: %zu < %zu\n", ws_size, (size_t)WS_NEED); return; }
    P p{};
    const float** f = (const float**)&p;
    for (int i = 0; i < 27; ++i) f[i] = (const float*)d_in[i];
    p.out = (float*)d_out; p.ws = (char*)d_ws;
#if MEGA
    static int grid_blocks = 0;
    if (!grid_blocks) {
        hipFuncSetAttribute((const void*)k_mega, hipFuncAttributeMaxDynamicSharedMemorySize, SMEM_BYTES);
        int dev = 0, cus = 0, per_cu = 0; hipGetDevice(&dev); hipDeviceGetAttribute(&cus, hipDeviceAttributeMultiprocessorCount, dev);
        hipOccupancyMaxActiveBlocksPerMultiprocessor(&per_cu, k_mega, 512, SMEM_BYTES);
        if (per_cu > 1) per_cu = 1;
        grid_blocks = cus * per_cu;
    }
    (void)hipMemsetAsync((char*)d_ws + OFF_BAR, 0, XCD_BAR_WORDS * 4, stream);
    void* args[] = {&p};
    hipError_t e = hipLaunchCooperativeKernel((const void*)k_mega, dim3(grid_blocks), dim3(512), args, SMEM_BYTES, stream);
    if (e != hipSuccess) fprintf(stderr, "cooperative launch failed: %s (grid %d)\n", hipGetErrorString(e), grid_blocks);
#else
    for (int layer = 0; layer < 2; ++layer) {
#define LP(ph) do { launch_phase<ph>(p, layer, stream); if (PROBE_PH == ph) { launch_phase<ph>(p, layer, stream); launch_phase<ph>(p, layer, stream); } } while (0)
        LP(0); LP(1); LP(2); LP(3); LP(4); LP(6); LP(7);
    }
    launch_phase<8>(p, 0, stream);
#endif
}
```
